# Optimizing an MI355X kernel written in HIP

```python
import math
import jax, jax.numpy as jnp
from jax import lax
import numpy as np

D_MODEL = 2048
BATCH = 1
SEQ = 8192
DEPTH = 1

MIX_WIDTH = D_MODEL
SSM_WIDTH = MIX_WIDTH // 2
SSM_GROUP = 16
SSM_GROUPS = SSM_WIDTH // SSM_GROUP
SSM_STATE = 64
SGU_WIDTH = MIX_WIDTH - SSM_WIDTH
SGU_HEADS = 8
SGU_HEAD_DIM = SGU_WIDTH // SGU_HEADS
SGU_CHUNK = 128
IN_WIDTH = SSM_WIDTH + 2 * SGU_WIDTH
D_FF = 4 * D_MODEL
EPS = 1e-6
DT_MIN = 1e-3
DT_MAX = 1e-1

kernel_name = "hymba_style_s5_sgu_hybrid_layer"


def rmsnorm(x, g):
    xf = x.astype(jnp.float32)
    xf = xf * lax.rsqrt(jnp.mean(xf * xf, axis=-1, keepdims=True) + EPS)
    return (xf * g.astype(jnp.float32)).astype(x.dtype)


def layernorm(x, g, b):
    xf = x.astype(jnp.float32)
    mu = jnp.mean(xf, axis=-1, keepdims=True)
    var = jnp.mean(jnp.square(xf - mu), axis=-1, keepdims=True)
    y = (xf - mu) * lax.rsqrt(var + EPS) * g.astype(jnp.float32) + b.astype(jnp.float32)
    return y.astype(x.dtype)


def _scan_combine(left, right):
    a_l, b_l = left
    a_r, b_r = right
    return a_l * a_r, a_r * b_l + b_r


def s5_mixer(u, a_re, a_im, b_re, b_im, c_re, c_im, d, log_dt, glu_w, glu_b):
    dtype = u.dtype
    bsz, seq, _ = u.shape
    uf = u.astype(jnp.float32).reshape(bsz, seq, SSM_GROUPS, SSM_GROUP)
    lam = lax.complex(a_re.astype(jnp.float32), a_im.astype(jnp.float32))
    dt = jnp.exp(log_dt.astype(jnp.float32))[:, None]
    a_bar = jnp.exp(lam * dt)
    b_mat = lax.complex(b_re.astype(jnp.float32), b_im.astype(jnp.float32))
    b_bar = ((a_bar - 1.0) / lam)[..., None] * b_mat
    bu = jnp.einsum('bsgh,gph->bsgp', uf.astype(jnp.complex64), b_bar)
    a_seq = jnp.broadcast_to(a_bar, bu.shape)
    _, states = lax.associative_scan(_scan_combine, (a_seq, bu), axis=1)
    c_mat = lax.complex(c_re.astype(jnp.float32), c_im.astype(jnp.float32))
    y = jnp.einsum('bsgp,ghp->bsgh', states, c_mat).real + d.astype(jnp.float32) * uf
    y = jax.nn.gelu(y.reshape(bsz, seq, SSM_WIDTH))
    gate = jax.nn.sigmoid(y @ glu_w.astype(jnp.float32) + glu_b.astype(jnp.float32))
    return (y * gate).astype(dtype)


def sgu_mixer(z, ln_g, ln_b, w_s, b_s):
    bsz, seq, _ = z.shape
    u, v = jnp.split(jax.nn.gelu(z), 2, axis=-1)
    v = layernorm(v, ln_g, ln_b)
    v = v.reshape(bsz, seq // SGU_CHUNK, SGU_CHUNK, SGU_HEADS, SGU_HEAD_DIM)
    causal = jnp.tril(jnp.ones((SGU_CHUNK, SGU_CHUNK), dtype=bool))
    w = jnp.where(causal[None], w_s, jnp.zeros_like(w_s))
    mixed = jnp.einsum('hts,bcshd->bcthd', w, v) + b_s.T[:, :, None]
    return u * mixed.reshape(bsz, seq, SGU_WIDTH)


def setup_inputs(seed: int = 0) -> dict:
    key = jax.random.key(seed)
    ks = jax.random.split(key, 24)
    L = DEPTH
    G, P, H = SSM_GROUPS, SSM_STATE, SSM_GROUP
    f32 = jnp.float32
    nrm = lambda k, shape: jax.random.normal(k, shape, f32)
    x = nrm(ks[0], (BATCH, SEQ, D_MODEL))
    norm_mix_g = 1.0 + 0.02 * nrm(ks[1], (L, D_MODEL))
    w_in = nrm(ks[2], (L, D_MODEL, IN_WIDTH)) * D_MODEL ** -0.5
    n = jnp.arange(P, dtype=f32)
    ssm_a_re = -0.5 + 0.01 * nrm(ks[3], (L, G, P))
    ssm_a_im = math.pi * n + 0.01 * nrm(ks[4], (L, G, P))
    ssm_b_re = nrm(ks[5], (L, G, P, H)) * (2.0 * H) ** -0.5
    ssm_b_im = nrm(ks[6], (L, G, P, H)) * (2.0 * H) ** -0.5
    ssm_c_re = nrm(ks[7], (L, G, H, P)) * (2.0 * P) ** -0.5
    ssm_c_im = nrm(ks[8], (L, G, H, P)) * (2.0 * P) ** -0.5
    ssm_d = nrm(ks[9], (L, G, H))
    ssm_log_dt = jax.random.uniform(ks[10], (L, G), f32, math.log(DT_MIN), math.log(DT_MAX))
    ssm_glu_w = nrm(ks[11], (L, SSM_WIDTH, SSM_WIDTH)) * SSM_WIDTH ** -0.5
    ssm_glu_b = 0.01 * nrm(ks[12], (L, SSM_WIDTH))
    sgu_ln_g = 1.0 + 0.02 * nrm(ks[13], (L, SGU_WIDTH))
    sgu_ln_b = 0.01 * nrm(ks[14], (L, SGU_WIDTH))
    sgu_w = nrm(ks[15], (L, SGU_HEADS, SGU_CHUNK, SGU_CHUNK)) * 0.5 * SGU_CHUNK ** -0.5
    sgu_b = 1.0 + 0.01 * nrm(ks[16], (L, SGU_HEADS, SGU_CHUNK))
    out_norm_ssm_g = 1.0 + 0.02 * nrm(ks[17], (L, SSM_WIDTH))
    out_norm_sgu_g = 1.0 + 0.02 * nrm(ks[18], (L, SGU_WIDTH))
    w_out = nrm(ks[19], (L, MIX_WIDTH, D_MODEL)) * MIX_WIDTH ** -0.5
    norm_mlp_g = 1.0 + 0.02 * nrm(ks[20], (L, D_MODEL))
    w_up = nrm(ks[21], (L, D_MODEL, D_FF)) * D_MODEL ** -0.5
    w_down = nrm(ks[22], (L, D_FF, D_MODEL)) * D_FF ** -0.5
    norm_final_g = 1.0 + 0.02 * nrm(ks[23], (D_MODEL,))
    return {"x": x, "norm_mix_g": norm_mix_g, "w_in": w_in,
            "ssm_a_re": ssm_a_re, "ssm_a_im": ssm_a_im,
            "ssm_b_re": ssm_b_re, "ssm_b_im": ssm_b_im,
            "ssm_c_re": ssm_c_re, "ssm_c_im": ssm_c_im,
            "ssm_d": ssm_d, "ssm_log_dt": ssm_log_dt,
            "ssm_glu_w": ssm_glu_w, "ssm_glu_b": ssm_glu_b,
            "sgu_ln_g": sgu_ln_g, "sgu_ln_b": sgu_ln_b,
            "sgu_w": sgu_w, "sgu_b": sgu_b,
            "out_norm_ssm_g": out_norm_ssm_g, "out_norm_sgu_g": out_norm_sgu_g,
            "w_out": w_out, "norm_mlp_g": norm_mlp_g,
            "w_up": w_up, "w_down": w_down, "norm_final_g": norm_final_g}


def reference(x, norm_mix_g, w_in, ssm_a_re, ssm_a_im, ssm_b_re, ssm_b_im,
              ssm_c_re, ssm_c_im, ssm_d, ssm_log_dt, ssm_glu_w, ssm_glu_b,
              sgu_ln_g, sgu_ln_b, sgu_w, sgu_b, out_norm_ssm_g, out_norm_sgu_g,
              w_out, norm_mlp_g, w_up, w_down, norm_final_g):
    for l in range(DEPTH):
        h = rmsnorm(x, norm_mix_g[l])
        z = h @ w_in[l]
        z_ssm = z[..., :SSM_WIDTH]
        z_sgu = z[..., SSM_WIDTH:]
        y_ssm = s5_mixer(z_ssm, ssm_a_re[l], ssm_a_im[l], ssm_b_re[l], ssm_b_im[l],
                         ssm_c_re[l], ssm_c_im[l], ssm_d[l], ssm_log_dt[l],
                         ssm_glu_w[l], ssm_glu_b[l])
        y_sgu = sgu_mixer(z_sgu, sgu_ln_g[l], sgu_ln_b[l], sgu_w[l], sgu_b[l])
        mixed = jnp.concatenate([rmsnorm(y_ssm, out_norm_ssm_g[l]),
                                 rmsnorm(y_sgu, out_norm_sgu_g[l])], axis=-1)
        x = x + mixed @ w_out[l]
        h = rmsnorm(x, norm_mlp_g[l])
        x = x + jnp.square(jax.nn.relu(h @ w_up[l])) @ w_down[l]
    return rmsnorm(x, norm_final_g)
```

```cpp
#include <hip/hip_runtime.h>
#include <cstdio>
#include <cstdint>
namespace pg8 {
#define PG8_LAS __attribute__((address_space(3)))
typedef unsigned short bf16_t;
typedef short bf16x8 __attribute__((ext_vector_type(8)));
typedef float f32x4 __attribute__((ext_vector_type(4)));
typedef unsigned u32x4 __attribute__((ext_vector_type(4)));
constexpr int BM = 256, BK = 64, HALF = 128, HTB = HALF * BK * 2  , STAGE_BYTES = 8 * HTB, NXCD = 8, WGM = 8;

__host__ __device__ __forceinline__ int lds_byte(int r, int c) { const int st = (r >> 4) * 2 + (c >> 5), rr = r & 15, cc = c & 31, ob = rr * 64 + cc * 2; return st * 1024 + (ob ^ (((ob >> 9) & 1) << 5)); }
__host__ __device__ __forceinline__ void stage_rc(int b, int& R, int& C) { const int st = b / 1024, sb = b % 1024, swz = sb ^ (((sb >> 9) & 1) << 5); R = (st >> 1) * 16 + swz / 64; C = (st & 1) * 32 + (swz % 64) / 2; }
__host__ __device__ __forceinline__ int perm32(int rho) { const int n = rho >> 4, i = rho & 15; return 8 * (i >> 2) + 4 * n + (i & 3); }

struct Unit { int pm, pn; };
struct Gemm { const bf16_t* A; const bf16_t* Bt; int M, N, K, pad; };

struct StaticOrder {
    int nM, nN, nwg, G, c;
    __host__ __device__ void init(int M, int N, int G_, int c_) { nM = M / BM; nN = N / BM; nwg = nM * nN; G = G_; c = c_; }
    __host__ __device__ bool next(int i, Unit& u) const {
        const long L = (long)i * G + c; if (L >= nwg) return false;
        int wgid = (int)L; { const int q = nwg / NXCD, r = nwg % NXCD, xcd = wgid % NXCD, off = wgid / NXCD; wgid = (xcd < r ? xcd * (q + 1) : r * (q + 1) + (xcd - r) * q) + off; }
        const int nig = WGM * nN, gid = wgid / nig, fm = gid * WGM, gsz = (nM - fm) < WGM ? (nM - fm) : WGM;
        u.pm = fm + ((wgid % nig) % gsz); u.pn = (wgid % nig) / gsz; return true;
    }
    __device__ __forceinline__ void a_ready(const Unit&) const {}
    __device__ __forceinline__ void done(const Unit&) const {}
};

__device__ __forceinline__ unsigned cvt_pk_bf16(float lo, float hi) { unsigned r; asm volatile("v_cvt_pk_bf16_f32 %0, %1, %2" : "=v"(r) : "v"(lo), "v"(hi)); return r; }
typedef float f32x2 __attribute__((ext_vector_type(2)));
template <class Epi, class Sched, bool ALIGN_EPI = false, bool SP2 = false>
__device__ __forceinline__ void gemm_phase(PG8_LAS unsigned char* lds, const Gemm g, const Sched& S, const Epi& E) {
    const int tid = threadIdx.x, wid = __builtin_amdgcn_readfirstlane(tid >> 6), lane = tid & 63, wr = wid >> 2, wc = wid & 3, fr = lane & 15, fq = lane >> 4;
    const int K = g.K, nt = K / BK;
    unsigned voffA[2], voffB[2];
#pragma unroll
    for (int i = 0; i < 2; ++i) { int R, C; stage_rc(tid * 16 + i * 8192, R, C); const int Rb = Epi::PERM ? ((R & ~31) + perm32(R & 31)) : R;
        voffA[i] = (unsigned)(R * K + C) * 2u; voffB[i] = (unsigned)(Rb * K + C) * 2u; }
    const size_t kstep = (size_t)(BK * 2);
    const size_t hstep = (size_t)HALF * K * 2;
    const size_t tstep = 2 * hstep;
    const unsigned ldsw = (unsigned)wid * 1024u;
    const int aoff = lds_byte(wr * 64 + fr, fq * 8), boff = lds_byte(wc * 32 + fr, fq * 8);
#define PG8_SA(b, h) (((b) * 2 + (h)) * HTB)
#define PG8_SB(b, h) ((4 + (b) * 2 + (h)) * HTB)
#define PG8_STAGE(bufoff, gbase, voff) do { _Pragma("unroll") for (int _i = 0; _i < 2; ++_i) \
        __builtin_amdgcn_global_load_lds((const unsigned*)((const char*)(gbase) + (voff)[_i]), (PG8_LAS unsigned*)(lds + (bufoff) + ldsw + _i * 8192), 16, 0, 0); } while (0)
#define PG8_LDA(dst, b, h) do { _Pragma("unroll") for (int m = 0; m < 4; ++m) _Pragma("unroll") for (int k = 0; k < 2; ++k) dst[m][k] = *(const PG8_LAS bf16x8*)(lds + PG8_SA(b, h) + aoff + m * 2048 + k * 1024); } while (0)
#define PG8_LDB(dst, b, h) do { _Pragma("unroll") for (int n = 0; n < 2; ++n) _Pragma("unroll") for (int k = 0; k < 2; ++k) dst[n][k] = *(const PG8_LAS bf16x8*)(lds + PG8_SB(b, h) + boff + n * 2048 + k * 1024); } while (0)
#define PG8_MMA(ai, bj, At, Bt) do { __builtin_amdgcn_s_setprio(1); _Pragma("unroll") for (int m = 0; m < 4; ++m) _Pragma("unroll") for (int n = 0; n < 2; ++n) _Pragma("unroll") for (int k = 0; k < 2; ++k) \
        acc[ai][bj][m][n] = __builtin_amdgcn_mfma_f32_16x16x32_bf16(Bt[n][k], At[m][k], acc[ai][bj][m][n], 0, 0, 0); __builtin_amdgcn_s_setprio(0); } while (0)
#define PG8_WAIT_V(n) asm volatile("s_waitcnt vmcnt(" #n ")" ::: "memory")
#define PG8_WAIT_L(n) asm volatile("s_waitcnt lgkmcnt(" #n ")" ::: "memory")
#define PG8_BAR __builtin_amdgcn_s_barrier()
#define PG8_SCHED __builtin_amdgcn_sched_barrier(0)
    Unit cur, nxt; int ui = 0;
    if (!S.next(0, cur)) return;
    f32x4 acc[2][2][4][2];
#pragma unroll
    for (int a = 0; a < 2; ++a)
#pragma unroll
        for (int b = 0; b < 2; ++b)
#pragma unroll
            for (int m = 0; m < 4; ++m)
#pragma unroll
                for (int n = 0; n < 2; ++n) acc[a][b][m][n] = (f32x4){0.f, 0.f, 0.f, 0.f};
    bf16x8 At[4][2], B0[2][2], B1[2][2];
    const char* cA = (const char*)g.A + (size_t)cur.pm * tstep; const char* cB = (const char*)g.Bt + (size_t)cur.pn * tstep;
    S.a_ready(cur);
    if constexpr (SP2) {
        PG8_STAGE(PG8_SB(0, 0), cB, voffB); PG8_STAGE(PG8_SB(0, 1), cB + hstep, voffB); PG8_STAGE(PG8_SA(0, 0), cA, voffA); PG8_STAGE(PG8_SA(0, 1), cA + hstep, voffA);
        if (wr == 1) PG8_BAR;
        PG8_WAIT_V(2); PG8_BAR;
        PG8_STAGE(PG8_SB(1, 0), cB + kstep, voffB); PG8_STAGE(PG8_SA(1, 0), cA + kstep, voffA); PG8_STAGE(PG8_SB(1, 1), cB + hstep + kstep, voffB);
        PG8_WAIT_V(6); PG8_BAR;
    } else {
        PG8_STAGE(PG8_SB(0, 0), cB, voffB); PG8_STAGE(PG8_SA(0, 0), cA, voffA); PG8_STAGE(PG8_SB(0, 1), cB + hstep, voffB); PG8_STAGE(PG8_SA(0, 1), cA + hstep, voffA);
        if (wr == 1) PG8_BAR;
        PG8_WAIT_V(4); PG8_BAR;
        PG8_STAGE(PG8_SB(1, 0), cB + kstep, voffB); PG8_STAGE(PG8_SA(1, 0), cA + kstep, voffA); PG8_STAGE(PG8_SB(1, 1), cB + hstep + kstep, voffB);
        PG8_WAIT_V(6); PG8_BAR;
    }
    for (;;) {
        const bool has_next = S.next(ui + 1, nxt);
        const char* nA = has_next ? (const char*)g.A + (size_t)nxt.pm * tstep : cA; const char* nB = has_next ? (const char*)g.Bt + (size_t)nxt.pn * tstep : cB;
        for (int t = 0; t < nt; t += 2) {
            const bool last = (t == nt - 2);
            const char* a1 = cA + (size_t)(t + 1) * kstep;
            const char* a2 = last ? nA : cA + (size_t)(t + 2) * kstep; const char* b2 = last ? nB : cB + (size_t)(t + 2) * kstep;
            const char* a3 = a2 + kstep; const char* b3 = b2 + kstep;
            if (last && has_next) S.a_ready(nxt);
            if constexpr (SP2) {
            PG8_LDB(B0, 0, 0); PG8_LDB(B1, 0, 1); PG8_SCHED; PG8_LDA(At, 0, 0); PG8_STAGE(PG8_SA(1, 1), a1 + hstep, voffA);
            PG8_WAIT_V(8); PG8_WAIT_L(0); PG8_BAR; PG8_MMA(0, 0, At, B0); PG8_MMA(0, 1, At, B1); PG8_BAR; PG8_SCHED;
            PG8_LDA(At, 0, 1); PG8_STAGE(PG8_SB(0, 0), b2, voffB); PG8_STAGE(PG8_SB(0, 1), b2 + hstep, voffB); PG8_STAGE(PG8_SA(0, 0), a2, voffA);
            PG8_WAIT_V(8); PG8_WAIT_L(0); PG8_BAR; PG8_MMA(1, 0, At, B0); PG8_MMA(1, 1, At, B1); PG8_BAR; PG8_SCHED;
            PG8_LDB(B0, 1, 0); PG8_LDB(B1, 1, 1); PG8_SCHED; PG8_LDA(At, 1, 0); PG8_STAGE(PG8_SA(0, 1), a2 + hstep, voffA);
            PG8_WAIT_V(8); PG8_WAIT_L(0); PG8_BAR; PG8_MMA(0, 0, At, B0); PG8_MMA(0, 1, At, B1); PG8_BAR; PG8_SCHED;
            PG8_LDA(At, 1, 1); PG8_STAGE(PG8_SB(1, 0), b3, voffB); PG8_STAGE(PG8_SB(1, 1), b3 + hstep, voffB); PG8_STAGE(PG8_SA(1, 0), a3, voffA);
            PG8_WAIT_V(8); PG8_WAIT_L(0); PG8_BAR; PG8_MMA(1, 0, At, B0); PG8_MMA(1, 1, At, B1); PG8_BAR; PG8_SCHED;
            } else {
            PG8_LDB(B0, 0, 0); PG8_SCHED; PG8_LDA(At, 0, 0); PG8_STAGE(PG8_SA(1, 1), a1 + hstep, voffA);
            PG8_WAIT_L(8); PG8_BAR; PG8_WAIT_L(0); PG8_MMA(0, 0, At, B0); PG8_BAR; PG8_SCHED;
            PG8_LDB(B1, 0, 1); PG8_STAGE(PG8_SB(0, 0), b2, voffB);
            PG8_BAR; PG8_WAIT_L(0); PG8_MMA(0, 1, At, B1); PG8_BAR;
            PG8_LDA(At, 0, 1); PG8_STAGE(PG8_SA(0, 0), a2, voffA);
            PG8_BAR; PG8_WAIT_L(0); PG8_MMA(1, 0, At, B0); PG8_BAR; PG8_SCHED;
            PG8_STAGE(PG8_SB(0, 1), b2 + hstep, voffB);
            PG8_WAIT_V(6); PG8_BAR; PG8_MMA(1, 1, At, B1); PG8_BAR;
            PG8_LDB(B0, 1, 0); PG8_SCHED; PG8_LDA(At, 1, 0); PG8_STAGE(PG8_SA(0, 1), a2 + hstep, voffA);
            PG8_WAIT_L(8); PG8_BAR; PG8_WAIT_L(0); PG8_MMA(0, 0, At, B0); PG8_BAR; PG8_SCHED;
            PG8_LDB(B1, 1, 1); PG8_STAGE(PG8_SB(1, 0), b3, voffB);
            PG8_BAR; PG8_WAIT_L(0); PG8_MMA(0, 1, At, B1); PG8_BAR;
            PG8_LDA(At, 1, 1); PG8_STAGE(PG8_SA(1, 0), a3, voffA);
            PG8_BAR; PG8_WAIT_L(0); PG8_MMA(1, 0, At, B0); PG8_BAR; PG8_SCHED;
            PG8_STAGE(PG8_SB(1, 1), b3 + hstep, voffB);
            PG8_WAIT_V(6); PG8_BAR; PG8_MMA(1, 1, At, B1); PG8_BAR;
            }
        }
        if constexpr (ALIGN_EPI) { if (wr == 0) PG8_BAR; }
        if constexpr (!Epi::AFTER_DRAIN) { E(acc, cur, wr, wc, fr, fq); S.done(cur); }
        if (!has_next) break;
#pragma unroll
        for (int a = 0; a < 2; ++a)
#pragma unroll
            for (int b = 0; b < 2; ++b)
#pragma unroll
                for (int m = 0; m < 4; ++m)
#pragma unroll
                    for (int n = 0; n < 2; ++n) acc[a][b][m][n] = (f32x4){0.f, 0.f, 0.f, 0.f};
        cur = nxt; cA = nA; cB = nB; ++ui;
        if constexpr (ALIGN_EPI) { if (wr == 1) PG8_BAR; }
    }
    PG8_WAIT_V(0);
    if constexpr (!ALIGN_EPI) { if (wr == 0) PG8_BAR; }
    PG8_BAR;
    if constexpr (Epi::AFTER_DRAIN) { E.fused(acc, cur, wr, wc, fr, fq, lds, wid, lane); S.done(cur); }
#undef PG8_SA
#undef PG8_SB
#undef PG8_STAGE
#undef PG8_LDA
#undef PG8_LDB
#undef PG8_MMA
#undef PG8_WAIT_V
#undef PG8_WAIT_L
#undef PG8_BAR
#undef PG8_SCHED
}
}
constexpr int SEQ = 8192, DM = 2048, SSMW = 1024, SGUW = 1024, INW = 3072, DFF = 8192;
constexpr int NG = 64, NP = 64, NHG = 16, SGH = 8, SGD = 128, SGC = 128;
constexpr float EPS = 1e-6f;
typedef unsigned short bf16;
typedef unsigned v4u __attribute__((ext_vector_type(4)));
typedef float f32x4 __attribute__((ext_vector_type(4)));
#define LAS __attribute__((address_space(3)))

__device__ __forceinline__ unsigned f2bf(float f) { unsigned u = __builtin_bit_cast(unsigned, f); return (u + 0x7fffu + ((u >> 16) & 1u)) >> 16; }
__device__ __forceinline__ unsigned pk2(float lo, float hi) { return f2bf(lo) | (f2bf(hi) << 16); }
__device__ __forceinline__ float bf2f(unsigned short b) { return __builtin_bit_cast(float, (unsigned)b << 16); }
__device__ __forceinline__ float bflo(unsigned w) { return __builtin_bit_cast(float, w << 16); }
__device__ __forceinline__ float bfhi(unsigned w) { return __builtin_bit_cast(float, w & 0xffff0000u); }
__device__ __forceinline__ float wave_sum(float v) {
#pragma unroll
    for (int o = 1; o < 64; o <<= 1) v += __shfl_xor(v, o);
    return v;
}
__device__ __forceinline__ float gelu_tanh(float x) { return 0.5f * x * (1.0f + tanhf(0.7978845608028654f * (x + 0.044715f * x * x * x))); }

namespace pg8 {
struct EpiF32 {
    static constexpr bool PERM = false, AFTER_DRAIN = false;
    float* out; const float* base; int ldc, pad;
    __device__ __forceinline__ void operator()(const f32x4 (&acc)[2][2][4][2], const Unit& u, int wr, int wc, int fr, int fq) const {
        const int row0 = u.pm * BM + wr * 64 + fr, col0 = u.pn * BM + wc * 32 + 4 * fq;
#pragma unroll
        for (int ai = 0; ai < 2; ++ai)
#pragma unroll
            for (int m = 0; m < 4; ++m) { const size_t off = (size_t)(row0 + ai * HALF + m * 16) * ldc + col0;
#pragma unroll
                for (int bj = 0; bj < 2; ++bj)
#pragma unroll
                    for (int n = 0; n < 2; ++n) { f32x4 v = acc[ai][bj][m][n]; if (base) v += *(const f32x4*)(base + off + bj * HALF + n * 16); *(f32x4*)(out + off + bj * HALF + n * 16) = v; } }
    }
};
template <int ACT  > struct EpiB {
    static constexpr bool PERM = true, AFTER_DRAIN = false;
    bf16_t* O; int ldc, pad;
    __device__ __forceinline__ void operator()(const f32x4 (&acc)[2][2][4][2], const Unit& u, int wr, int wc, int fr, int fq) const {
        const int row0 = u.pm * BM + wr * 64 + fr, col0 = u.pn * BM + wc * 32 + 8 * fq;
#pragma unroll
        for (int ai = 0; ai < 2; ++ai)
#pragma unroll
            for (int m = 0; m < 4; ++m) { bf16_t* rowp = O + (size_t)(row0 + ai * HALF + m * 16) * ldc + col0;
#pragma unroll
                for (int bj = 0; bj < 2; ++bj) { f32x4 v0 = acc[ai][bj][m][0], v1 = acc[ai][bj][m][1];
                    if (ACT == 2) {
#pragma unroll
                        for (int e = 0; e < 4; ++e) { float a = fmaxf(v0[e], 0.f), b = fmaxf(v1[e], 0.f); v0[e] = a * a; v1[e] = b * b; } }
                    u32x4 w; w.x = cvt_pk_bf16(v0[0], v0[1]); w.y = cvt_pk_bf16(v0[2], v0[3]); w.z = cvt_pk_bf16(v1[0], v1[1]); w.w = cvt_pk_bf16(v1[2], v1[3]);
                    *(u32x4*)(rowp + bj * HALF) = w; } }
    }
};
}

template <class Epi>
__global__ void __launch_bounds__(512, 2) gemm_k(pg8::Gemm g, Epi E) {
    extern __shared__ __attribute__((aligned(16))) unsigned char lds[];
    pg8::StaticOrder S; S.init(g.M, g.N, (int)gridDim.x, (int)blockIdx.x);
    pg8::gemm_phase<Epi, pg8::StaticOrder, true, true>((PG8_LAS unsigned char*)lds, g, S, E);
}

__device__ __forceinline__ void transpose_item(const float* W, int K, int N, const float* s0, const float* s1, int split, bf16* WT, LAS float* scr, int item, int lane) {
    const int nblk = N / 32, kb = item / nblk, nb = item % nblk, k0 = 64 * kb, n0 = 32 * nb;
#pragma unroll 8
    for (int i = 0; i < 32; ++i) { const int kk = 2 * i + (lane >> 5); const int k = k0 + kk;
        float sc = 1.0f; if (s0) sc = (k < split) ? s0[k] : s1[k - split];
        scr[kk * 33 + (lane & 31)] = W[(size_t)k * N + n0 + (lane & 31)] * sc; }
    asm volatile("s_waitcnt lgkmcnt(0)" ::: "memory");
    const int c = lane & 7;
#pragma unroll
    for (int j = 0; j < 4; ++j) { const int n = (lane >> 3) + 8 * j; const LAS float* s = scr + (8 * c) * 33 + n;
        v4u o; o.x = pk2(s[0 * 33], s[1 * 33]); o.y = pk2(s[2 * 33], s[3 * 33]); o.z = pk2(s[4 * 33], s[5 * 33]); o.w = pk2(s[6 * 33], s[7 * 33]);
        *(v4u*)(WT + (size_t)(n0 + n) * K + k0 + 8 * c) = o; }
    asm volatile("s_waitcnt lgkmcnt(0)" ::: "memory");
}
__global__ void __launch_bounds__(512) k_convT(const float* W, int K, int N, const float* s0, const float* s1, int split, bf16* WT) {
    __shared__ float scr_all[8][64 * 33];
    const int wid = threadIdx.x >> 6, lane = threadIdx.x & 63;
    LAS float* scr = (LAS float*)scr_all[wid];
    const int nitems = (K / 64) * (N / 32);
    for (int it = blockIdx.x * 8 + wid; it < nitems; it += gridDim.x * 8) transpose_item(W, K, N, s0, s1, split, WT, scr, it, lane);
}

__global__ void __launch_bounds__(512) k_rms_bf16(const float* x, bf16* out, int rows) {
    const int wid = threadIdx.x >> 6, lane = threadIdx.x & 63;
    for (int r = blockIdx.x * 8 + wid; r < rows; r += gridDim.x * 8) {
        const f32x4* xr = (const f32x4*)(x + (size_t)r * DM) + lane; f32x4 v[8]; float ss = 0.f;
#pragma unroll
        for (int j = 0; j < 8; ++j) { v[j] = xr[64 * j]; ss += (v[j].x * v[j].x + v[j].y * v[j].y) + (v[j].z * v[j].z + v[j].w * v[j].w); }
        const float rs = 1.0f / sqrtf(wave_sum(ss) * (1.0f / DM) + EPS);
        unsigned long long* o8 = (unsigned long long*)(out + (size_t)r * DM) + lane;
#pragma unroll
        for (int j = 0; j < 8; ++j) o8[64 * j] = (unsigned long long)pk2(v[j].x * rs, v[j].y * rs) | ((unsigned long long)pk2(v[j].z * rs, v[j].w * rs) << 32);
    }
}
__global__ void __launch_bounds__(512) k_final_rms(float* x, const float* g, int rows) {
    const int wid = threadIdx.x >> 6, lane = threadIdx.x & 63;
    for (int r = blockIdx.x * 8 + wid; r < rows; r += gridDim.x * 8) {
        f32x4* xr = (f32x4*)(x + (size_t)r * DM) + lane; const f32x4* gr = (const f32x4*)g + lane; f32x4 v[8]; float ss = 0.f;
#pragma unroll
        for (int j = 0; j < 8; ++j) { v[j] = xr[64 * j]; ss += (v[j].x * v[j].x + v[j].y * v[j].y) + (v[j].z * v[j].z + v[j].w * v[j].w); }
        const float rs = 1.0f / sqrtf(wave_sum(ss) * (1.0f / DM) + EPS);
#pragma unroll
        for (int j = 0; j < 8; ++j) xr[64 * j] = v[j] * rs * gr[64 * j];
    }
}

__global__ void k_ssm_params(const float* a_re, const float* a_im, const float* b_re, const float* b_im, const float* log_dt,
                             float* A  , float* A64  , float* BB  ) {
    const int i = blockIdx.x * blockDim.x + threadIdx.x; if (i >= NG * NP) return;
    const int g = i / NP;
    const double dt = exp((double)log_dt[g]);
    const double lr = a_re[i], li = a_im[i];
    const double zr = lr * dt, zi = li * dt, ea = exp(zr);
    const double ar = ea * cos(zi), ai = ea * sin(zi);
    const double d2 = lr * lr + li * li;
    const double qr = ((ar - 1.0) * lr + ai * li) / d2, qi = (ai * lr - (ar - 1.0) * li) / d2;
    A[2 * i] = (float)ar; A[2 * i + 1] = (float)ai;
    double pr = ar, pi = ai;
    for (int k = 0; k < 6; ++k) { const double nr = pr * pr - pi * pi, ni = 2.0 * pr * pi; pr = nr; pi = ni; }
    A64[2 * i] = (float)pr; A64[2 * i + 1] = (float)pi;
    for (int h = 0; h < NHG; ++h) { const double br = b_re[i * NHG + h], bi = b_im[i * NHG + h];
        BB[(i * NHG + h) * 2] = (float)(qr * br - qi * bi); BB[(i * NHG + h) * 2 + 1] = (float)(qr * bi + qi * br); }
}
constexpr int NCH = 128, LCH = 64;
__device__ __forceinline__ void load_u16(const bf16* zp, float (&u)[16]) {
    const v4u w0 = *(const v4u*)zp, w1 = *(const v4u*)(zp + 8);
    u[0] = bflo(w0.x); u[1] = bfhi(w0.x); u[2] = bflo(w0.y); u[3] = bfhi(w0.y); u[4] = bflo(w0.z); u[5] = bfhi(w0.z); u[6] = bflo(w0.w); u[7] = bfhi(w0.w);
    u[8] = bflo(w1.x); u[9] = bfhi(w1.x); u[10] = bflo(w1.y); u[11] = bfhi(w1.y); u[12] = bflo(w1.z); u[13] = bfhi(w1.z); u[14] = bflo(w1.w); u[15] = bfhi(w1.w);
}
__global__ void __launch_bounds__(512) k_ssm_pass1(const bf16* ZB, const float* A, const float* BB, float* E) {
    const int wid = threadIdx.x >> 6, lane = threadIdx.x & 63;
    const int item = blockIdx.x * 8 + wid; const int g = item / NCH, c = item % NCH, p = lane, gp = g * NP + p;
    const float ar = A[2 * gp], ai = A[2 * gp + 1];
    float bbr[16], bbi[16];
#pragma unroll
    for (int h = 0; h < 16; ++h) { bbr[h] = BB[(gp * 16 + h) * 2]; bbi[h] = BB[(gp * 16 + h) * 2 + 1]; }
    float xr = 0.f, xi = 0.f;
    for (int t = 0; t < LCH; ++t) {
        const int token = c * LCH + t; float u[16]; load_u16(ZB + (size_t)token * INW + g * 16, u);
        float bur = 0.f, bui = 0.f;
#pragma unroll
        for (int h = 0; h < 16; ++h) { bur += bbr[h] * u[h]; bui += bbi[h] * u[h]; }
        const float nr = ar * xr - ai * xi + bur, ni = ar * xi + ai * xr + bui; xr = nr; xi = ni;
    }
    E[((size_t)(g * NCH + c) * NP + p) * 2] = xr; E[((size_t)(g * NCH + c) * NP + p) * 2 + 1] = xi;
}
__global__ void k_ssm_carry(const float* A64, const float* E, float* XIN) {
    const int i = blockIdx.x * blockDim.x + threadIdx.x; if (i >= NG * NP) return;
    const int g = i / NP, p = i % NP; const float ar = A64[2 * i], ai = A64[2 * i + 1];
    float xr = 0.f, xi = 0.f;
    for (int c = 0; c < NCH; ++c) { const size_t o = ((size_t)(g * NCH + c) * NP + p) * 2;
        XIN[o] = xr; XIN[o + 1] = xi;
        const float er = E[o], ei = E[o + 1]; const float nr = ar * xr - ai * xi + er, ni = ar * xi + ai * xr + ei; xr = nr; xi = ni; }
}
__global__ void __launch_bounds__(512) k_ssm_pass3(const bf16* ZB, const float* A, const float* BB, const float* XIN, const float* c_re, const float* c_im, const float* dskip, bf16* YACT) {
    __shared__ float sm[8][16 * 65];
    const int wid = threadIdx.x >> 6, lane = threadIdx.x & 63;
    const int item = blockIdx.x * 8 + wid; const int g = item / NCH, c = item % NCH, p = lane, gp = g * NP + p;
    const float ar = A[2 * gp], ai = A[2 * gp + 1];
    float bbr[16], bbi[16], cr[16], ci[16];
#pragma unroll
    for (int h = 0; h < 16; ++h) { bbr[h] = BB[(gp * 16 + h) * 2]; bbi[h] = BB[(gp * 16 + h) * 2 + 1]; cr[h] = c_re[(g * 16 + h) * NP + p]; ci[h] = c_im[(g * 16 + h) * NP + p]; }
    const size_t xo = ((size_t)(g * NCH + c) * NP + p) * 2;
    float xr = XIN[xo], xi = XIN[xo + 1];
    const int hh = lane & 15, q = lane >> 4; const float dh = dskip[g * 16 + hh];
    for (int t = 0; t < LCH; ++t) {
        const int token = c * LCH + t; const bf16* zp = ZB + (size_t)token * INW + g * 16; float u[16]; load_u16(zp, u);
        float bur = 0.f, bui = 0.f;
#pragma unroll
        for (int h = 0; h < 16; ++h) { bur += bbr[h] * u[h]; bui += bbi[h] * u[h]; }
        const float nr = ar * xr - ai * xi + bur, ni = ar * xi + ai * xr + bui; xr = nr; xi = ni;
#pragma unroll
        for (int h = 0; h < 16; ++h) sm[wid][h * 65 + p] = cr[h] * xr - ci[h] * xi;
        __syncthreads();
        float s = 0.f;
#pragma unroll
        for (int j = 0; j < 16; ++j) s += sm[wid][hh * 65 + q * 16 + j];
        s += __shfl_xor(s, 16); s += __shfl_xor(s, 32);
        if (lane < 16) { const float uh = bf2f(zp[hh]); const float y = s + dh * uh; YACT[(size_t)token * SSMW + g * 16 + hh] = (bf16)f2bf(gelu_tanh(y)); }
        __syncthreads();
    }
}

__global__ void __launch_bounds__(512) k_sgu_ln(const bf16* ZB, const float* lg, const float* lb, float* VLN) {
    const int wid = threadIdx.x >> 6, lane = threadIdx.x & 63;
    for (int r = blockIdx.x * 8 + wid; r < SEQ; r += gridDim.x * 8) {
        float v[16]; float s = 0.f;
#pragma unroll
        for (int half = 0; half < 2; ++half) { const v4u w = *(const v4u*)(ZB + (size_t)r * INW + 2048 + half * 512 + lane * 8);
            const float t8[8] = {bflo(w.x), bfhi(w.x), bflo(w.y), bfhi(w.y), bflo(w.z), bfhi(w.z), bflo(w.w), bfhi(w.w)};
#pragma unroll
            for (int j = 0; j < 8; ++j) { v[half * 8 + j] = gelu_tanh(t8[j]); s += v[half * 8 + j]; } }
        const float mu = wave_sum(s) * (1.0f / SGUW); float q = 0.f;
#pragma unroll
        for (int j = 0; j < 16; ++j) { v[j] -= mu; q += v[j] * v[j]; }
        const float rstd = 1.0f / sqrtf(wave_sum(q) * (1.0f / SGUW) + EPS);
#pragma unroll
        for (int half = 0; half < 2; ++half)
#pragma unroll
            for (int j = 0; j < 8; ++j) { const int ch = half * 512 + lane * 8 + j; VLN[(size_t)r * SGUW + ch] = v[half * 8 + j] * rstd * lg[ch] + lb[ch]; }
    }
}
__global__ void __launch_bounds__(256) k_sgu_mix(const bf16* ZB, const float* VLN, const float* w, const float* bs, float* YSGU) {
    const int token = blockIdx.x >> 2, seg = blockIdx.x & 3, ch = seg * 256 + threadIdx.x, h = ch >> 7, c = token >> 7, t = token & 127;
    const float* wr = w + ((size_t)h * SGC + t) * SGC; const float* vp = VLN + (size_t)(c * SGC) * SGUW + ch;
    float acc = 0.f;
    for (int s = 0; s <= t; ++s) acc += wr[s] * vp[(size_t)s * SGUW];
    const float mixed = acc + bs[h * SGC + t];
    const float zu = bf2f(ZB[(size_t)token * INW + 1024 + ch]);
    YSGU[(size_t)token * SGUW + ch] = gelu_tanh(zu) * mixed;
}
__global__ void __launch_bounds__(512) k_outnorm(const bf16* YACT, const float* GLUC, const float* glub, const float* YSGU, bf16* AOUT) {
    const int wid = threadIdx.x >> 6, lane = threadIdx.x & 63;
    for (int r = blockIdx.x * 8 + wid; r < SEQ; r += gridDim.x * 8) {
        float a[16], b[16]; float sa = 0.f, sb = 0.f;
#pragma unroll
        for (int j = 0; j < 16; ++j) { const int ch = (j >> 3) * 512 + lane * 8 + (j & 7);
            const float y = bf2f(YACT[(size_t)r * SSMW + ch]); const float gt = 1.0f / (1.0f + expf(-(GLUC[(size_t)r * SSMW + ch] + glub[ch])));
            a[j] = y * gt; sa += a[j] * a[j]; b[j] = YSGU[(size_t)r * SGUW + ch]; sb += b[j] * b[j]; }
        const float ra = 1.0f / sqrtf(wave_sum(sa) * (1.0f / SSMW) + EPS), rb = 1.0f / sqrtf(wave_sum(sb) * (1.0f / SGUW) + EPS);
#pragma unroll
        for (int j = 0; j < 16; ++j) { const int ch = (j >> 3) * 512 + lane * 8 + (j & 7);
            AOUT[(size_t)r * DM + ch] = (bf16)f2bf(a[j] * ra); AOUT[(size_t)r * DM + 1024 + ch] = (bf16)f2bf(b[j] * rb); }
    }
}

constexpr size_t MiB = 1u << 20;
constexpr size_t WS_WUPT = 1 * MiB, WS_WDOWNT = 33 * MiB, WS_AMLP = 65 * MiB, WS_H = 97 * MiB;
constexpr size_t WS_WINT = 97 * MiB, WS_GLUT = 109 * MiB, WS_WOUTT = 111 * MiB, WS_H0 = 119 * MiB, WS_ZB = 151 * MiB, WS_VLN = 199 * MiB, WS_YACT = 231 * MiB;
constexpr size_t WS_E = 247 * MiB, WS_XIN = 251 * MiB, WS_PAR = 255 * MiB, WS_END = 256 * MiB;
constexpr size_t WS_YSGU = WS_AMLP, WS_GLUC = WS_H0, WS_AOUT = WS_VLN;
constexpr int GEMM_LDS = pg8::STAGE_BYTES;

template <class Epi> static void run_gemm(const bf16* A, const bf16* Bt, int M, int N, int K, Epi E, hipStream_t s) {
    static bool attr = false;
    if (!attr) { (void)hipFuncSetAttribute((const void*)gemm_k<Epi>, hipFuncAttributeMaxDynamicSharedMemorySize, GEMM_LDS); attr = true; }
    pg8::Gemm g{A, Bt, M, N, K, 0};
    hipLaunchKernelGGL(gemm_k<Epi>, dim3(256), dim3(512), GEMM_LDS, s, g, E);
}

extern "C" void kernel_launch(void* const* d_in, const int* in_sizes, int n_in, void* d_out, int out_size, void* d_ws, size_t ws_size, hipStream_t stream) {
    if (n_in != 24 || ws_size < WS_END) { fprintf(stderr, "kernel_launch: unexpected n_in %d / ws %zu\n", n_in, ws_size); return; }
    const float* x = (const float*)d_in[0]; const float* g_mix = (const float*)d_in[1]; const float* w_in = (const float*)d_in[2];
    const float* a_re = (const float*)d_in[3]; const float* a_im = (const float*)d_in[4]; const float* b_re = (const float*)d_in[5]; const float* b_im = (const float*)d_in[6];
    const float* c_re = (const float*)d_in[7]; const float* c_im = (const float*)d_in[8]; const float* ssm_d = (const float*)d_in[9]; const float* log_dt = (const float*)d_in[10];
    const float* glu_w = (const float*)d_in[11]; const float* glu_b = (const float*)d_in[12]; const float* ln_g = (const float*)d_in[13]; const float* ln_b = (const float*)d_in[14];
    const float* sgu_w = (const float*)d_in[15]; const float* sgu_b = (const float*)d_in[16]; const float* g_ssm = (const float*)d_in[17]; const float* g_sgu = (const float*)d_in[18];
    const float* w_out = (const float*)d_in[19]; const float* g_mlp = (const float*)d_in[20]; const float* w_up = (const float*)d_in[21]; const float* w_down = (const float*)d_in[22];
    const float* g_fin = (const float*)d_in[23];
    float* out = (float*)d_out; unsigned char* ws = (unsigned char*)d_ws;
    bf16* WUPT = (bf16*)(ws + WS_WUPT); bf16* WDOWNT = (bf16*)(ws + WS_WDOWNT); bf16* AMLP = (bf16*)(ws + WS_AMLP); bf16* H = (bf16*)(ws + WS_H);
    bf16* WINT = (bf16*)(ws + WS_WINT); bf16* GLUT = (bf16*)(ws + WS_GLUT); bf16* WOUTT = (bf16*)(ws + WS_WOUTT); bf16* H0 = (bf16*)(ws + WS_H0);
    bf16* ZB = (bf16*)(ws + WS_ZB); float* VLN = (float*)(ws + WS_VLN); bf16* YACT = (bf16*)(ws + WS_YACT);
    float* E = (float*)(ws + WS_E); float* XIN = (float*)(ws + WS_XIN); float* PA = (float*)(ws + WS_PAR); float* PA64 = PA + 2 * NG * NP; float* PBB = PA64 + 2 * NG * NP;
    float* YSGU = (float*)(ws + WS_YSGU); float* GLUC = (float*)(ws + WS_GLUC); bf16* AOUT = (bf16*)(ws + WS_AOUT);

    hipLaunchKernelGGL(k_convT, dim3(1024), dim3(512), 0, stream, w_in, DM, INW, g_mix, g_mix, DM, WINT);
    hipLaunchKernelGGL(k_convT, dim3(512), dim3(512), 0, stream, glu_w, SSMW, SSMW, (const float*)nullptr, (const float*)nullptr, 0, GLUT);
    hipLaunchKernelGGL(k_convT, dim3(1024), dim3(512), 0, stream, w_out, DM, DM, g_ssm, g_sgu, SSMW, WOUTT);
    hipLaunchKernelGGL(k_convT, dim3(1024), dim3(512), 0, stream, w_up, DM, DFF, g_mlp, g_mlp, DM, WUPT);
    hipLaunchKernelGGL(k_convT, dim3(1024), dim3(512), 0, stream, w_down, DFF, DM, (const float*)nullptr, (const float*)nullptr, 0, WDOWNT);
    hipLaunchKernelGGL(k_rms_bf16, dim3(1024), dim3(512), 0, stream, x, H0, SEQ);
    run_gemm(H0, WINT, SEQ, INW, DM, pg8::EpiB<0>{ZB, INW, 0}, stream);
    hipLaunchKernelGGL(k_ssm_params, dim3(16), dim3(256), 0, stream, a_re, a_im, b_re, b_im, log_dt, PA, PA64, PBB);
    hipLaunchKernelGGL(k_ssm_pass1, dim3(NG * NCH / 8), dim3(512), 0, stream, ZB, PA, PBB, E);
    hipLaunchKernelGGL(k_ssm_carry, dim3(16), dim3(256), 0, stream, PA64, E, XIN);
    hipLaunchKernelGGL(k_ssm_pass3, dim3(NG * NCH / 8), dim3(512), 0, stream, ZB, PA, PBB, XIN, c_re, c_im, ssm_d, YACT);
    run_gemm(YACT, GLUT, SEQ, SSMW, SSMW, pg8::EpiF32{GLUC, nullptr, SSMW, 0}, stream);
    hipLaunchKernelGGL(k_sgu_ln, dim3(1024), dim3(512), 0, stream, ZB, ln_g, ln_b, VLN);
    hipLaunchKernelGGL(k_sgu_mix, dim3(SEQ * 4), dim3(256), 0, stream, ZB, VLN, sgu_w, sgu_b, YSGU);
    hipLaunchKernelGGL(k_outnorm, dim3(1024), dim3(512), 0, stream, YACT, GLUC, glu_b, YSGU, AOUT);
    run_gemm(AOUT, WOUTT, SEQ, DM, DM, pg8::EpiF32{out, x, DM, 0}, stream);
    hipLaunchKernelGGL(k_rms_bf16, dim3(1024), dim3(512), 0, stream, (const float*)out, AMLP, SEQ);
    run_gemm(AMLP, WUPT, SEQ, DFF, DM, pg8::EpiB<2>{H, DFF, 0}, stream);
    run_gemm(H, WDOWNT, SEQ, DM, DFF, pg8::EpiF32{out, out, DM, 0}, stream);
    hipLaunchKernelGGL(k_final_rms, dim3(1024), dim3(512), 0, stream, out, g_fin, SEQ);
}
```

```cpp
#include <hip/hip_runtime.h>
#include <cstdio>
#include <cstdint>
namespace pg8 {
#define PG8_LAS __attribute__((address_space(3)))
typedef unsigned short bf16_t;
typedef short bf16x8 __attribute__((ext_vector_type(8)));
typedef float f32x4 __attribute__((ext_vector_type(4)));
typedef unsigned u32x4 __attribute__((ext_vector_type(4)));
constexpr int BM = 256, BK = 64, HALF = 128, HTB = HALF * BK * 2  , STAGE_BYTES = 8 * HTB, NXCD = 8, WGM = 8;

__host__ __device__ __forceinline__ int lds_byte(int r, int c) { const int st = (r >> 4) * 2 + (c >> 5), rr = r & 15, cc = c & 31, ob = rr * 64 + cc * 2; return st * 1024 + (ob ^ (((ob >> 9) & 1) << 5)); }
__host__ __device__ __forceinline__ void stage_rc(int b, int& R, int& C) { const int st = b / 1024, sb = b % 1024, swz = sb ^ (((sb >> 9) & 1) << 5); R = (st >> 1) * 16 + swz / 64; C = (st & 1) * 32 + (swz % 64) / 2; }
__host__ __device__ __forceinline__ int perm32(int rho) { const int n = rho >> 4, i = rho & 15; return 8 * (i >> 2) + 4 * n + (i & 3); }

struct Unit { int pm, pn; };
struct Gemm { const bf16_t* A; const bf16_t* Bt; int M, N, K, pad; };

struct StaticOrder {
    int nM, nN, nwg, G, c;
    __host__ __device__ void init(int M, int N, int G_, int c_) { nM = M / BM; nN = N / BM; nwg = nM * nN; G = G_; c = c_; }
    __host__ __device__ bool next(int i, Unit& u) const {
        const long L = (long)i * G + c; if (L >= nwg) return false;
        int wgid = (int)L; { const int q = nwg / NXCD, r = nwg % NXCD, xcd = wgid % NXCD, off = wgid / NXCD; wgid = (xcd < r ? xcd * (q + 1) : r * (q + 1) + (xcd - r) * q) + off; }
        const int nig = WGM * nN, gid = wgid / nig, fm = gid * WGM, gsz = (nM - fm) < WGM ? (nM - fm) : WGM;
        u.pm = fm + ((wgid % nig) % gsz); u.pn = (wgid % nig) / gsz; return true;
    }
    __device__ __forceinline__ void a_ready(const Unit&) const {}
    __device__ __forceinline__ void done(const Unit&) const {}
};

__device__ __forceinline__ unsigned cvt_pk_bf16(float lo, float hi) { unsigned r; asm volatile("v_cvt_pk_bf16_f32 %0, %1, %2" : "=v"(r) : "v"(lo), "v"(hi)); return r; }
typedef float f32x2 __attribute__((ext_vector_type(2)));
template <class Epi, class Sched, bool ALIGN_EPI = false, bool SP2 = false>
__device__ __forceinline__ void gemm_phase(PG8_LAS unsigned char* lds, const Gemm g, const Sched& S, const Epi& E) {
    const int tid = threadIdx.x, wid = __builtin_amdgcn_readfirstlane(tid >> 6), lane = tid & 63, wr = wid >> 2, wc = wid & 3, fr = lane & 15, fq = lane >> 4;
    const int K = g.K, nt = K / BK;
    unsigned voffA[2], voffB[2];
#pragma unroll
    for (int i = 0; i < 2; ++i) { int R, C; stage_rc(tid * 16 + i * 8192, R, C); const int Rb = Epi::PERM ? ((R & ~31) + perm32(R & 31)) : R;
        voffA[i] = (unsigned)(R * K + C) * 2u; voffB[i] = (unsigned)(Rb * K + C) * 2u; }
    const size_t kstep = (size_t)(BK * 2);
    const size_t hstep = (size_t)HALF * K * 2;
    const size_t tstep = 2 * hstep;
    const unsigned ldsw = (unsigned)wid * 1024u;
    const int aoff = lds_byte(wr * 64 + fr, fq * 8), boff = lds_byte(wc * 32 + fr, fq * 8);
#define PG8_SA(b, h) (((b) * 2 + (h)) * HTB)
#define PG8_SB(b, h) ((4 + (b) * 2 + (h)) * HTB)
#define PG8_STAGE(bufoff, gbase, voff) do { _Pragma("unroll") for (int _i = 0; _i < 2; ++_i) \
        __builtin_amdgcn_global_load_lds((const unsigned*)((const char*)(gbase) + (voff)[_i]), (PG8_LAS unsigned*)(lds + (bufoff) + ldsw + _i * 8192), 16, 0, 0); } while (0)
#define PG8_LDA(dst, b, h) do { _Pragma("unroll") for (int m = 0; m < 4; ++m) _Pragma("unroll") for (int k = 0; k < 2; ++k) dst[m][k] = *(const PG8_LAS bf16x8*)(lds + PG8_SA(b, h) + aoff + m * 2048 + k * 1024); } while (0)
#define PG8_LDB(dst, b, h) do { _Pragma("unroll") for (int n = 0; n < 2; ++n) _Pragma("unroll") for (int k = 0; k < 2; ++k) dst[n][k] = *(const PG8_LAS bf16x8*)(lds + PG8_SB(b, h) + boff + n * 2048 + k * 1024); } while (0)
#define PG8_MMA(ai, bj, At, Bt) do { __builtin_amdgcn_s_setprio(1); _Pragma("unroll") for (int m = 0; m < 4; ++m) _Pragma("unroll") for (int n = 0; n < 2; ++n) _Pragma("unroll") for (int k = 0; k < 2; ++k) \
        acc[ai][bj][m][n] = __builtin_amdgcn_mfma_f32_16x16x32_bf16(Bt[n][k], At[m][k], acc[ai][bj][m][n], 0, 0, 0); __builtin_amdgcn_s_setprio(0); } while (0)
#define PG8_WAIT_V(n) asm volatile("s_waitcnt vmcnt(" #n ")" ::: "memory")
#define PG8_WAIT_L(n) asm volatile("s_waitcnt lgkmcnt(" #n ")" ::: "memory")
#define PG8_BAR __builtin_amdgcn_s_barrier()
#define PG8_SCHED __builtin_amdgcn_sched_barrier(0)
    Unit cur, nxt; int ui = 0;
    if (!S.next(0, cur)) return;
    f32x4 acc[2][2][4][2];
#pragma unroll
    for (int a = 0; a < 2; ++a)
#pragma unroll
        for (int b = 0; b < 2; ++b)
#pragma unroll
            for (int m = 0; m < 4; ++m)
#pragma unroll
                for (int n = 0; n < 2; ++n) acc[a][b][m][n] = (f32x4){0.f, 0.f, 0.f, 0.f};
    bf16x8 At[4][2], B0[2][2], B1[2][2];
    const char* cA = (const char*)g.A + (size_t)cur.pm * tstep; const char* cB = (const char*)g.Bt + (size_t)cur.pn * tstep;
    S.a_ready(cur);
    if constexpr (SP2) {
        PG8_STAGE(PG8_SB(0, 0), cB, voffB); PG8_STAGE(PG8_SB(0, 1), cB + hstep, voffB); PG8_STAGE(PG8_SA(0, 0), cA, voffA); PG8_STAGE(PG8_SA(0, 1), cA + hstep, voffA);
        if (wr == 1) PG8_BAR;
        PG8_WAIT_V(2); PG8_BAR;
        PG8_STAGE(PG8_SB(1, 0), cB + kstep, voffB); PG8_STAGE(PG8_SA(1, 0), cA + kstep, voffA); PG8_STAGE(PG8_SB(1, 1), cB + hstep + kstep, voffB);
        PG8_WAIT_V(6); PG8_BAR;
    } else {
        PG8_STAGE(PG8_SB(0, 0), cB, voffB); PG8_STAGE(PG8_SA(0, 0), cA, voffA); PG8_STAGE(PG8_SB(0, 1), cB + hstep, voffB); PG8_STAGE(PG8_SA(0, 1), cA + hstep, voffA);
        if (wr == 1) PG8_BAR;
        PG8_WAIT_V(4); PG8_BAR;
        PG8_STAGE(PG8_SB(1, 0), cB + kstep, voffB); PG8_STAGE(PG8_SA(1, 0), cA + kstep, voffA); PG8_STAGE(PG8_SB(1, 1), cB + hstep + kstep, voffB);
        PG8_WAIT_V(6); PG8_BAR;
    }
    for (;;) {
        const bool has_next = S.next(ui + 1, nxt);
        const char* nA = has_next ? (const char*)g.A + (size_t)nxt.pm * tstep : cA; const char* nB = has_next ? (const char*)g.Bt + (size_t)nxt.pn * tstep : cB;
        for (int t = 0; t < nt; t += 2) {
            const bool last = (t == nt - 2);
            const char* a1 = cA + (size_t)(t + 1) * kstep;
            const char* a2 = last ? nA : cA + (size_t)(t + 2) * kstep; const char* b2 = last ? nB : cB + (size_t)(t + 2) * kstep;
            const char* a3 = a2 + kstep; const char* b3 = b2 + kstep;
            if (last && has_next) S.a_ready(nxt);
            if constexpr (SP2) {
            PG8_LDB(B0, 0, 0); PG8_LDB(B1, 0, 1); PG8_SCHED; PG8_LDA(At, 0, 0); PG8_STAGE(PG8_SA(1, 1), a1 + hstep, voffA);
            PG8_WAIT_V(8); PG8_WAIT_L(0); PG8_BAR; PG8_MMA(0, 0, At, B0); PG8_MMA(0, 1, At, B1); PG8_BAR; PG8_SCHED;
            PG8_LDA(At, 0, 1); PG8_STAGE(PG8_SB(0, 0), b2, voffB); PG8_STAGE(PG8_SB(0, 1), b2 + hstep, voffB); PG8_STAGE(PG8_SA(0, 0), a2, voffA);
            PG8_WAIT_V(8); PG8_WAIT_L(0); PG8_BAR; PG8_MMA(1, 0, At, B0); PG8_MMA(1, 1, At, B1); PG8_BAR; PG8_SCHED;
            PG8_LDB(B0, 1, 0); PG8_LDB(B1, 1, 1); PG8_SCHED; PG8_LDA(At, 1, 0); PG8_STAGE(PG8_SA(0, 1), a2 + hstep, voffA);
            PG8_WAIT_V(8); PG8_WAIT_L(0); PG8_BAR; PG8_MMA(0, 0, At, B0); PG8_MMA(0, 1, At, B1); PG8_BAR; PG8_SCHED;
            PG8_LDA(At, 1, 1); PG8_STAGE(PG8_SB(1, 0), b3, voffB); PG8_STAGE(PG8_SB(1, 1), b3 + hstep, voffB); PG8_STAGE(PG8_SA(1, 0), a3, voffA);
            PG8_WAIT_V(8); PG8_WAIT_L(0); PG8_BAR; PG8_MMA(1, 0, At, B0); PG8_MMA(1, 1, At, B1); PG8_BAR; PG8_SCHED;
            } else {
            PG8_LDB(B0, 0, 0); PG8_SCHED; PG8_LDA(At, 0, 0); PG8_STAGE(PG8_SA(1, 1), a1 + hstep, voffA);
            PG8_WAIT_L(8); PG8_BAR; PG8_WAIT_L(0); PG8_MMA(0, 0, At, B0); PG8_BAR; PG8_SCHED;
            PG8_LDB(B1, 0, 1); PG8_STAGE(PG8_SB(0, 0), b2, voffB);
            PG8_BAR; PG8_WAIT_L(0); PG8_MMA(0, 1, At, B1); PG8_BAR;
            PG8_LDA(At, 0, 1); PG8_STAGE(PG8_SA(0, 0), a2, voffA);
            PG8_BAR; PG8_WAIT_L(0); PG8_MMA(1, 0, At, B0); PG8_BAR; PG8_SCHED;
            PG8_STAGE(PG8_SB(0, 1), b2 + hstep, voffB);
            PG8_WAIT_V(6); PG8_BAR; PG8_MMA(1, 1, At, B1); PG8_BAR;
            PG8_LDB(B0, 1, 0); PG8_SCHED; PG8_LDA(At, 1, 0); PG8_STAGE(PG8_SA(0, 1), a2 + hstep, voffA);
            PG8_WAIT_L(8); PG8_BAR; PG8_WAIT_L(0); PG8_MMA(0, 0, At, B0); PG8_BAR; PG8_SCHED;
            PG8_LDB(B1, 1, 1); PG8_STAGE(PG8_SB(1, 0), b3, voffB);
            PG8_BAR; PG8_WAIT_L(0); PG8_MMA(0, 1, At, B1); PG8_BAR;
            PG8_LDA(At, 1, 1); PG8_STAGE(PG8_SA(1, 0), a3, voffA);
            PG8_BAR; PG8_WAIT_L(0); PG8_MMA(1, 0, At, B0); PG8_BAR; PG8_SCHED;
            PG8_STAGE(PG8_SB(1, 1), b3 + hstep, voffB);
            PG8_WAIT_V(6); PG8_BAR; PG8_MMA(1, 1, At, B1); PG8_BAR;
            }
        }
        if constexpr (ALIGN_EPI) { if (wr == 0) PG8_BAR; }
        if constexpr (!Epi::AFTER_DRAIN) { E(acc, cur, wr, wc, fr, fq); S.done(cur); }
        if (!has_next) break;
#pragma unroll
        for (int a = 0; a < 2; ++a)
#pragma unroll
            for (int b = 0; b < 2; ++b)
#pragma unroll
                for (int m = 0; m < 4; ++m)
#pragma unroll
                    for (int n = 0; n < 2; ++n) acc[a][b][m][n] = (f32x4){0.f, 0.f, 0.f, 0.f};
        cur = nxt; cA = nA; cB = nB; ++ui;
        if constexpr (ALIGN_EPI) { if (wr == 1) PG8_BAR; }
    }
    PG8_WAIT_V(0);
    if constexpr (!ALIGN_EPI) { if (wr == 0) PG8_BAR; }
    PG8_BAR;
    if constexpr (Epi::AFTER_DRAIN) { E.fused(acc, cur, wr, wc, fr, fq, lds, wid, lane); S.done(cur); }
#undef PG8_SA
#undef PG8_SB
#undef PG8_STAGE
#undef PG8_LDA
#undef PG8_LDB
#undef PG8_MMA
#undef PG8_WAIT_V
#undef PG8_WAIT_L
#undef PG8_BAR
#undef PG8_SCHED
}
}
constexpr int SEQ = 8192, DM = 2048, SSMW = 1024, SGUW = 1024, INW = 3072, DFF = 8192;
constexpr int NG = 64, NP = 64, NHG = 16, SGH = 8, SGD = 128, SGC = 128;
constexpr float EPS = 1e-6f;
typedef unsigned short bf16;
typedef unsigned v4u __attribute__((ext_vector_type(4)));
typedef float f32x4 __attribute__((ext_vector_type(4)));
#define LAS __attribute__((address_space(3)))

__device__ __forceinline__ unsigned f2bf(float f) { unsigned u = __builtin_bit_cast(unsigned, f); return (u + 0x7fffu + ((u >> 16) & 1u)) >> 16; }
__device__ __forceinline__ unsigned pk2(float lo, float hi) { return f2bf(lo) | (f2bf(hi) << 16); }
__device__ __forceinline__ float bf2f(unsigned short b) { return __builtin_bit_cast(float, (unsigned)b << 16); }
__device__ __forceinline__ float bflo(unsigned w) { return __builtin_bit_cast(float, w << 16); }
__device__ __forceinline__ float bfhi(unsigned w) { return __builtin_bit_cast(float, w & 0xffff0000u); }
__device__ __forceinline__ float wave_sum(float v) {
#pragma unroll
    for (int o = 1; o < 64; o <<= 1) v += __shfl_xor(v, o);
    return v;
}
__device__ __forceinline__ float gelu_tanh(float x) { return 0.5f * x * (1.0f + tanhf(0.7978845608028654f * (x + 0.044715f * x * x * x))); }

namespace pg8 {
struct EpiF32 {
    static constexpr bool PERM = false, AFTER_DRAIN = false;
    float* out; const float* base; int ldc, pad;
    __device__ __forceinline__ void operator()(const f32x4 (&acc)[2][2][4][2], const Unit& u, int wr, int wc, int fr, int fq) const {
        const int row0 = u.pm * BM + wr * 64 + fr, col0 = u.pn * BM + wc * 32 + 4 * fq;
#pragma unroll
        for (int ai = 0; ai < 2; ++ai)
#pragma unroll
            for (int m = 0; m < 4; ++m) { const size_t off = (size_t)(row0 + ai * HALF + m * 16) * ldc + col0;
#pragma unroll
                for (int bj = 0; bj < 2; ++bj)
#pragma unroll
                    for (int n = 0; n < 2; ++n) { f32x4 v = acc[ai][bj][m][n]; if (base) v += *(const f32x4*)(base + off + bj * HALF + n * 16); *(f32x4*)(out + off + bj * HALF + n * 16) = v; } }
    }
};
template <int ACT  > struct EpiB {
    static constexpr bool PERM = true, AFTER_DRAIN = false;
    bf16_t* O; int ldc, pad;
    __device__ __forceinline__ void operator()(const f32x4 (&acc)[2][2][4][2], const Unit& u, int wr, int wc, int fr, int fq) const {
        const int row0 = u.pm * BM + wr * 64 + fr, col0 = u.pn * BM + wc * 32 + 8 * fq;
#pragma unroll
        for (int ai = 0; ai < 2; ++ai)
#pragma unroll
            for (int m = 0; m < 4; ++m) { bf16_t* rowp = O + (size_t)(row0 + ai * HALF + m * 16) * ldc + col0;
#pragma unroll
                for (int bj = 0; bj < 2; ++bj) { f32x4 v0 = acc[ai][bj][m][0], v1 = acc[ai][bj][m][1];
                    if (ACT == 2) {
#pragma unroll
                        for (int e = 0; e < 4; ++e) { float a = fmaxf(v0[e], 0.f), b = fmaxf(v1[e], 0.f); v0[e] = a * a; v1[e] = b * b; } }
                    u32x4 w; w.x = cvt_pk_bf16(v0[0], v0[1]); w.y = cvt_pk_bf16(v0[2], v0[3]); w.z = cvt_pk_bf16(v1[0], v1[1]); w.w = cvt_pk_bf16(v1[2], v1[3]);
                    *(u32x4*)(rowp + bj * HALF) = w; } }
    }
};
}

#define XB_TMO      128
#define XB_XCNT(j)  (256  + 64 * (j))
#define XB_XSUB(j)  (1280 + 64 * (j))
#define XB_XGEN(j)  (2304 + 64 * (j))
#define XB_TOP      3328
#define XB_TOPGEN   3392
#define XCD_BAR_WORDS 3456
#define XB_SPIN_CAP (1u << 18)

__device__ __forceinline__ unsigned xb_ld(unsigned* p)              { return __hip_atomic_load(p, __ATOMIC_RELAXED, __HIP_MEMORY_SCOPE_AGENT); }
__device__ __forceinline__ unsigned xb_add(unsigned* p, unsigned v) { return __hip_atomic_fetch_add(p, v, __ATOMIC_RELAXED, __HIP_MEMORY_SCOPE_AGENT); }
__device__ __forceinline__ unsigned xb_xcc_id() { return (unsigned)__builtin_amdgcn_s_getreg((3 << 11) | 20) & 0xFu; }
#define XB_SPIN(cond, bar) do { unsigned _sp = 0; while (cond) { __builtin_amdgcn_s_sleep(1); \
    if ((++_sp & 255u) == 0u) { if (xb_ld(&(bar)[XB_TMO])) break; if (_sp > XB_SPIN_CAP) { atomicAdd(&(bar)[XB_TMO], 1u); break; } } } } while (0)

struct XcdBarrier {
    unsigned* bar; unsigned x;
    volatile LAS unsigned* st;
};

__device__ __forceinline__ XcdBarrier xcd_barrier_post(unsigned* bar, volatile LAS unsigned* st) {
    XcdBarrier b; b.bar = bar; b.x = xb_xcc_id(); b.st = st;
    if (threadIdx.x == 0) (void)xb_add(&bar[XB_XCNT(b.x)], 1u);
    return b;
}
__device__ __forceinline__ void xcd_barrier_complete(unsigned* bar, unsigned x, unsigned& nloc, unsigned& nx) {
    const unsigned G = gridDim.x * gridDim.y * gridDim.z;
    unsigned sum, cnt, mine, sp = 0u;
    for (;;) {
        sum = 0u; cnt = 0u; mine = 0u;
#pragma unroll
        for (unsigned j = 0; j < 16; ++j) { const unsigned c = xb_ld(&bar[XB_XCNT(j)]); sum += c; cnt += (c > 0u) ? 1u : 0u; mine = (j == x) ? c : mine; }
        if (sum == G) break;
        __builtin_amdgcn_s_sleep(1);
        if ((++sp & 255u) == 0u) { if (xb_ld(&bar[XB_TMO])) break; if (sp > XB_SPIN_CAP) { atomicAdd(&bar[XB_TMO], 1u); break; } }
    }
    nloc = mine > 0u ? mine : 1u; nx = cnt > 0u ? cnt : 1u;
}

__device__ __forceinline__ void xcd_barrier(const XcdBarrier& b) {
    asm volatile("s_waitcnt vmcnt(0)" ::: "memory");
    __syncthreads();
    if (threadIdx.x == 0) {
        unsigned* bar = b.bar;
        __builtin_amdgcn_s_waitcnt(0);
        unsigned nloc = b.st[0], nx = b.st[1];
        if (nloc == 0u) { xcd_barrier_complete(bar, b.x, nloc, nx); b.st[0] = nloc; b.st[1] = nx; }
        const unsigned old = xb_add(&bar[XB_XSUB(b.x)], 1u);
        const unsigned gen = old / nloc;
        if (old + 1u == (gen + 1u) * nloc) {
            __builtin_amdgcn_fence(__ATOMIC_RELEASE, "agent");
            asm volatile("s_waitcnt vmcnt(0)" ::: "memory");
            const unsigned og = xb_add(&bar[XB_TOP], 1u);
            const unsigned tg = og / nx;
            if (og + 1u == (tg + 1u) * nx) xb_add(&bar[XB_TOPGEN], 1u);
            else XB_SPIN(xb_ld(&bar[XB_TOPGEN]) == tg, bar);
            __builtin_amdgcn_fence(__ATOMIC_ACQUIRE, "agent");
            xb_add(&bar[XB_XGEN(b.x)], 1u);
            asm volatile("s_waitcnt vmcnt(0)" ::: "memory");
        } else {
            XB_SPIN(xb_ld(&bar[XB_XGEN(b.x)]) == gen, bar);
            __builtin_amdgcn_fence(__ATOMIC_ACQUIRE, "agent");
            asm volatile("s_waitcnt vmcnt(0)" ::: "memory");
        }
    }
    __syncthreads();
}
constexpr size_t MiB = 1u << 20;
constexpr size_t WS_CTL = 0, CTL_ZERO_BYTES = 64 * 1024;
constexpr size_t WS_WUPT = 1 * MiB, WS_WDOWNT = 33 * MiB, WS_AMLP = 65 * MiB, WS_H = 97 * MiB;
constexpr size_t WS_WINT = 97 * MiB, WS_GLUT = 109 * MiB, WS_WOUTT = 111 * MiB, WS_H0 = 119 * MiB, WS_ZB = 151 * MiB, WS_VLN = 199 * MiB, WS_YACT = 231 * MiB;
constexpr size_t WS_E = 247 * MiB, WS_XIN = 251 * MiB, WS_PAR = 255 * MiB, WS_END = 256 * MiB;
constexpr size_t WS_YSGU = WS_AMLP, WS_GLUC = WS_H0, WS_AOUT = WS_VLN;
constexpr int CW_BAR = 4096;
constexpr int RING_OFF = 0, RING_BYTES = 131072;
constexpr int MISC_OFF = RING_BYTES + 320;
constexpr int LDS_BYTES = 147456;
constexpr int NWAVES = 8;
typedef __attribute__((address_space(1))) unsigned gu32;
#define RLX_AGENT __ATOMIC_RELAXED, __HIP_MEMORY_SCOPE_AGENT

struct Ctx { LAS unsigned char* lds; int tid, lane, wave, gw, ngw; };

__device__ __forceinline__ void transpose_item(const float* W, int K, int N, const float* s0, const float* s1, int split, bf16* WT, LAS float* scr, int item, int lane) {
    const int nblk = N / 32, kb = item / nblk, nb = item % nblk, k0 = 64 * kb, n0 = 32 * nb;
#pragma unroll 8
    for (int i = 0; i < 32; ++i) { const int kk = 2 * i + (lane >> 5); const int k = k0 + kk;
        float sc = 1.0f; if (s0) sc = (k < split) ? s0[k] : s1[k - split];
        scr[kk * 33 + (lane & 31)] = W[(size_t)k * N + n0 + (lane & 31)] * sc; }
    asm volatile("s_waitcnt lgkmcnt(0)" ::: "memory");
    const int c = lane & 7;
#pragma unroll
    for (int j = 0; j < 4; ++j) { const int n = (lane >> 3) + 8 * j; const LAS float* s = scr + (8 * c) * 33 + n;
        v4u o; o.x = pk2(s[0 * 33], s[1 * 33]); o.y = pk2(s[2 * 33], s[3 * 33]); o.z = pk2(s[4 * 33], s[5 * 33]); o.w = pk2(s[6 * 33], s[7 * 33]);
        *(v4u*)(WT + (size_t)(n0 + n) * K + k0 + 8 * c) = o; }
    asm volatile("s_waitcnt lgkmcnt(0)" ::: "memory");
}
__device__ __forceinline__ void rms_row_bf16(const float* xrow, bf16* orow, int lane) {
    const f32x4* xr = (const f32x4*)xrow + lane; f32x4 v[8]; float ss = 0.f;
#pragma unroll
    for (int j = 0; j < 8; ++j) { v[j] = xr[64 * j]; ss += (v[j].x * v[j].x + v[j].y * v[j].y) + (v[j].z * v[j].z + v[j].w * v[j].w); }
    const float rs = 1.0f / sqrtf(wave_sum(ss) * (1.0f / DM) + EPS);
    unsigned long long* o8 = (unsigned long long*)orow + lane;
#pragma unroll
    for (int j = 0; j < 8; ++j) o8[64 * j] = (unsigned long long)pk2(v[j].x * rs, v[j].y * rs) | ((unsigned long long)pk2(v[j].z * rs, v[j].w * rs) << 32);
}
__device__ __forceinline__ void final_rms_row(float* xrow, const float* g, int lane) {
    f32x4* xr = (f32x4*)xrow + lane; const f32x4* gr = (const f32x4*)g + lane; f32x4 v[8]; float ss = 0.f;
#pragma unroll
    for (int j = 0; j < 8; ++j) { v[j] = xr[64 * j]; ss += (v[j].x * v[j].x + v[j].y * v[j].y) + (v[j].z * v[j].z + v[j].w * v[j].w); }
    const float rs = 1.0f / sqrtf(wave_sum(ss) * (1.0f / DM) + EPS);
#pragma unroll
    for (int j = 0; j < 8; ++j) xr[64 * j] = v[j] * rs * gr[64 * j];
}
__device__ __forceinline__ void ssm_params(int i, const float* a_re, const float* a_im, const float* b_re, const float* b_im, const float* log_dt, float* A, float* A64, float* BB) {
    const int g = i / NP;
    const double dt = exp((double)log_dt[g]);
    const double lr = a_re[i], li = a_im[i];
    const double zr = lr * dt, zi = li * dt, ea = exp(zr);
    const double ar = ea * cos(zi), ai = ea * sin(zi);
    const double d2 = lr * lr + li * li;
    const double qr = ((ar - 1.0) * lr + ai * li) / d2, qi = (ai * lr - (ar - 1.0) * li) / d2;
    A[2 * i] = (float)ar; A[2 * i + 1] = (float)ai;
    double pr = ar, pi = ai;
    for (int k = 0; k < 6; ++k) { const double nr = pr * pr - pi * pi, ni = 2.0 * pr * pi; pr = nr; pi = ni; }
    A64[2 * i] = (float)pr; A64[2 * i + 1] = (float)pi;
    for (int h = 0; h < NHG; ++h) { const double br = b_re[i * NHG + h], bi = b_im[i * NHG + h];
        BB[(i * NHG + h) * 2] = (float)(qr * br - qi * bi); BB[(i * NHG + h) * 2 + 1] = (float)(qr * bi + qi * br); }
}
constexpr int NCH = 128, LCH = 64;
__device__ __forceinline__ void load_u16(const bf16* zp, float (&u)[16]) {
    const v4u w0 = *(const v4u*)zp, w1 = *(const v4u*)(zp + 8);
    u[0] = bflo(w0.x); u[1] = bfhi(w0.x); u[2] = bflo(w0.y); u[3] = bfhi(w0.y); u[4] = bflo(w0.z); u[5] = bfhi(w0.z); u[6] = bflo(w0.w); u[7] = bfhi(w0.w);
    u[8] = bflo(w1.x); u[9] = bfhi(w1.x); u[10] = bflo(w1.y); u[11] = bfhi(w1.y); u[12] = bflo(w1.z); u[13] = bfhi(w1.z); u[14] = bflo(w1.w); u[15] = bfhi(w1.w);
}
__device__ __forceinline__ void ssm_pass1_item(int item, int lane, const bf16* ZB, const float* A, const float* BB, float* E) {
    const int g = item / NCH, c = item % NCH, p = lane, gp = g * NP + p;
    const float ar = A[2 * gp], ai = A[2 * gp + 1];
    float bbr[16], bbi[16];
#pragma unroll
    for (int h = 0; h < 16; ++h) { bbr[h] = BB[(gp * 16 + h) * 2]; bbi[h] = BB[(gp * 16 + h) * 2 + 1]; }
    float xr = 0.f, xi = 0.f;
    for (int t = 0; t < LCH; ++t) {
        const int token = c * LCH + t; float u[16]; load_u16(ZB + (size_t)token * INW + g * 16, u);
        float bur = 0.f, bui = 0.f;
#pragma unroll
        for (int h = 0; h < 16; ++h) { bur += bbr[h] * u[h]; bui += bbi[h] * u[h]; }
        const float nr = ar * xr - ai * xi + bur, ni = ar * xi + ai * xr + bui; xr = nr; xi = ni;
    }
    E[((size_t)(g * NCH + c) * NP + p) * 2] = xr; E[((size_t)(g * NCH + c) * NP + p) * 2 + 1] = xi;
}
__device__ __forceinline__ void ssm_carry(int i, const float* A64, const float* E, float* XIN) {
    const int g = i / NP, p = i % NP; const float ar = A64[2 * i], ai = A64[2 * i + 1];
    float xr = 0.f, xi = 0.f;
    for (int c = 0; c < NCH; ++c) { const size_t o = ((size_t)(g * NCH + c) * NP + p) * 2;
        XIN[o] = xr; XIN[o + 1] = xi;
        const float er = E[o], ei = E[o + 1]; const float nr = ar * xr - ai * xi + er, ni = ar * xi + ai * xr + ei; xr = nr; xi = ni; }
}
__device__ __forceinline__ void ssm_pass3_item(int item, int lane, LAS float* sm, const bf16* ZB, const float* A, const float* BB, const float* XIN, const float* c_re, const float* c_im, const float* dskip, bf16* YACT) {
    const int g = item / NCH, c = item % NCH, p = lane, gp = g * NP + p;
    const float ar = A[2 * gp], ai = A[2 * gp + 1];
    float bbr[16], bbi[16], cr[16], ci[16];
#pragma unroll
    for (int h = 0; h < 16; ++h) { bbr[h] = BB[(gp * 16 + h) * 2]; bbi[h] = BB[(gp * 16 + h) * 2 + 1]; cr[h] = c_re[(g * 16 + h) * NP + p]; ci[h] = c_im[(g * 16 + h) * NP + p]; }
    const size_t xo = ((size_t)(g * NCH + c) * NP + p) * 2;
    float xr = XIN[xo], xi = XIN[xo + 1];
    const int hh = lane & 15, q = lane >> 4; const float dh = dskip[g * 16 + hh];
    for (int t = 0; t < LCH; ++t) {
        const int token = c * LCH + t; const bf16* zp = ZB + (size_t)token * INW + g * 16; float u[16]; load_u16(zp, u);
        float bur = 0.f, bui = 0.f;
#pragma unroll
        for (int h = 0; h < 16; ++h) { bur += bbr[h] * u[h]; bui += bbi[h] * u[h]; }
        const float nr = ar * xr - ai * xi + bur, ni = ar * xi + ai * xr + bui; xr = nr; xi = ni;
#pragma unroll
        for (int h = 0; h < 16; ++h) sm[h * 65 + p] = cr[h] * xr - ci[h] * xi;
        __syncthreads();
        float s = 0.f;
#pragma unroll
        for (int j = 0; j < 16; ++j) s += sm[hh * 65 + q * 16 + j];
        s += __shfl_xor(s, 16); s += __shfl_xor(s, 32);
        if (lane < 16) { const float uh = bf2f(zp[hh]); const float y = s + dh * uh; YACT[(size_t)token * SSMW + g * 16 + hh] = (bf16)f2bf(gelu_tanh(y)); }
        __syncthreads();
    }
}
__device__ __forceinline__ void sgu_ln_row(int r, int lane, const bf16* ZB, const float* lg, const float* lb, float* VLN) {
    float v[16]; float s = 0.f;
#pragma unroll
    for (int half = 0; half < 2; ++half) { const v4u w = *(const v4u*)(ZB + (size_t)r * INW + 2048 + half * 512 + lane * 8);
        const float t8[8] = {bflo(w.x), bfhi(w.x), bflo(w.y), bfhi(w.y), bflo(w.z), bfhi(w.z), bflo(w.w), bfhi(w.w)};
#pragma unroll
        for (int j = 0; j < 8; ++j) { v[half * 8 + j] = gelu_tanh(t8[j]); s += v[half * 8 + j]; } }
    const float mu = wave_sum(s) * (1.0f / SGUW); float q = 0.f;
#pragma unroll
    for (int j = 0; j < 16; ++j) { v[j] -= mu; q += v[j] * v[j]; }
    const float rstd = 1.0f / sqrtf(wave_sum(q) * (1.0f / SGUW) + EPS);
#pragma unroll
    for (int half = 0; half < 2; ++half)
#pragma unroll
        for (int j = 0; j < 8; ++j) { const int ch = half * 512 + lane * 8 + j; VLN[(size_t)r * SGUW + ch] = v[half * 8 + j] * rstd * lg[ch] + lb[ch]; }
}
__device__ __forceinline__ void sgu_mix_item(int it, int tid, const bf16* ZB, const float* VLN, const float* w, const float* bs, float* YSGU) {
    const int token = it >> 1, ch = (it & 1) * 512 + tid, h = ch >> 7, c = token >> 7, t = token & 127;
    const float* wr = w + ((size_t)h * SGC + t) * SGC; const float* vp = VLN + (size_t)(c * SGC) * SGUW + ch;
    float acc = 0.f;
    for (int s = 0; s <= t; ++s) acc += wr[s] * vp[(size_t)s * SGUW];
    const float mixed = acc + bs[h * SGC + t];
    const float zu = bf2f(ZB[(size_t)token * INW + 1024 + ch]);
    YSGU[(size_t)token * SGUW + ch] = gelu_tanh(zu) * mixed;
}
__device__ __forceinline__ void outnorm_row(int r, int lane, const bf16* YACT, const float* GLUC, const float* glub, const float* YSGU, bf16* AOUT) {
    float a[16], b[16]; float sa = 0.f, sb = 0.f;
#pragma unroll
    for (int j = 0; j < 16; ++j) { const int ch = (j >> 3) * 512 + lane * 8 + (j & 7);
        const float y = bf2f(YACT[(size_t)r * SSMW + ch]); const float gt = 1.0f / (1.0f + expf(-(GLUC[(size_t)r * SSMW + ch] + glub[ch])));
        a[j] = y * gt; sa += a[j] * a[j]; b[j] = YSGU[(size_t)r * SGUW + ch]; sb += b[j] * b[j]; }
    const float ra = 1.0f / sqrtf(wave_sum(sa) * (1.0f / SSMW) + EPS), rb = 1.0f / sqrtf(wave_sum(sb) * (1.0f / SGUW) + EPS);
#pragma unroll
    for (int j = 0; j < 16; ++j) { const int ch = (j >> 3) * 512 + lane * 8 + (j & 7);
        AOUT[(size_t)r * DM + ch] = (bf16)f2bf(a[j] * ra); AOUT[(size_t)r * DM + 1024 + ch] = (bf16)f2bf(b[j] * rb); }
}
#ifndef MK_N_LAUNCHES
#define MK_N_LAUNCHES 1
#endif
constexpr int PER_PHASE = 12;
constexpr int N_LAUNCHES = MK_N_LAUNCHES;
struct Args { const float* in[24]; float* out; unsigned char* ws; int ph_lo, ph_hi; };
static_assert(sizeof(Args) == 24 * 8 + 8 + 8 + 8, "Args has no padding");

__global__ void __launch_bounds__(NWAVES * 64, 2) fwd(Args args) {
    extern __shared__ __attribute__((aligned(16))) unsigned char lds_raw[];
    LAS unsigned char* L = (LAS unsigned char*)lds_raw;
    const int tid = threadIdx.x, lane = tid & 63, wave = __builtin_amdgcn_readfirstlane(tid >> 6);
    const int gw = blockIdx.x * NWAVES + wave, ngw = gridDim.x * NWAVES;
    volatile LAS unsigned* MISC = (volatile LAS unsigned*)(L + MISC_OFF);
    for (int u = tid; u < 32; u += NWAVES * 64) MISC[u] = 0u;
    __syncthreads();
    unsigned char* ws = args.ws;
    XcdBarrier bar; bar.bar = (unsigned*)(ws + WS_CTL) + CW_BAR; bar.x = 0; bar.st = nullptr;
    if (N_LAUNCHES != PER_PHASE) bar = xcd_barrier_post((unsigned*)(ws + WS_CTL) + CW_BAR, MISC + 8);
    const float* x = args.in[0]; const float* g_mix = args.in[1]; const float* w_in = args.in[2];
    const float* a_re = args.in[3]; const float* a_im = args.in[4]; const float* b_re = args.in[5]; const float* b_im = args.in[6];
    const float* c_re = args.in[7]; const float* c_im = args.in[8]; const float* ssm_d = args.in[9]; const float* log_dt = args.in[10];
    const float* glu_w = args.in[11]; const float* glu_b = args.in[12]; const float* ln_g = args.in[13]; const float* ln_b = args.in[14];
    const float* sgu_w = args.in[15]; const float* sgu_b = args.in[16]; const float* g_ssm = args.in[17]; const float* g_sgu = args.in[18];
    const float* w_out = args.in[19]; const float* g_mlp = args.in[20]; const float* w_up = args.in[21]; const float* w_down = args.in[22];
    const float* g_fin = args.in[23];
    float* out = args.out;
    bf16* WUPT = (bf16*)(ws + WS_WUPT); bf16* WDOWNT = (bf16*)(ws + WS_WDOWNT); bf16* AMLP = (bf16*)(ws + WS_AMLP); bf16* H = (bf16*)(ws + WS_H);
    bf16* WINT = (bf16*)(ws + WS_WINT); bf16* GLUT = (bf16*)(ws + WS_GLUT); bf16* WOUTT = (bf16*)(ws + WS_WOUTT); bf16* H0 = (bf16*)(ws + WS_H0);
    bf16* ZB = (bf16*)(ws + WS_ZB); float* VLN = (float*)(ws + WS_VLN); bf16* YACT = (bf16*)(ws + WS_YACT);
    float* E = (float*)(ws + WS_E); float* XIN = (float*)(ws + WS_XIN); float* PA = (float*)(ws + WS_PAR); float* PA64 = PA + 2 * NG * NP; float* PBB = PA64 + 2 * NG * NP;
    float* YSGU = (float*)(ws + WS_YSGU); float* GLUC = (float*)(ws + WS_GLUC); bf16* AOUT = (bf16*)(ws + WS_AOUT);

    const int lo = args.ph_lo, hi = args.ph_hi;
#define IN(k) (lo <= (k) && (k) < hi)
#define SEAM(k) do { if (IN(k) && IN((k) + 1)) xcd_barrier(bar); } while (0)
#define GEMM_PHASE(EPI, A_, BT_, M_, N_, K_, ...) do { pg8::Gemm g{A_, BT_, M_, N_, K_, 0}; pg8::StaticOrder S; S.init(M_, N_, (int)gridDim.x, (int)blockIdx.x); \
        EPI Ep{__VA_ARGS__}; pg8::gemm_phase<EPI, pg8::StaticOrder, true, true>(L + RING_OFF, g, S, Ep); } while (0)

    if (IN(0)) {
        LAS float* scr = (LAS float*)(L + RING_OFF + wave * 16384);
        constexpr int I_IN = (DM / 64) * (INW / 32), I_GLU = (SSMW / 64) * (SSMW / 32), I_OUT = (DM / 64) * (DM / 32), I_UP = (DM / 64) * (DFF / 32), I_DN = (DFF / 64) * (DM / 32);
        constexpr int NITEMS = I_IN + I_GLU + I_OUT + I_UP + I_DN;
        for (int it = gw; it < NITEMS; it += ngw) {
            int r = it;
            if (r < I_IN) { transpose_item(w_in, DM, INW, g_mix, g_mix, DM, WINT, scr, r, lane); continue; } r -= I_IN;
            if (r < I_GLU) { transpose_item(glu_w, SSMW, SSMW, nullptr, nullptr, 0, GLUT, scr, r, lane); continue; } r -= I_GLU;
            if (r < I_OUT) { transpose_item(w_out, DM, DM, g_ssm, g_sgu, SSMW, WOUTT, scr, r, lane); continue; } r -= I_OUT;
            if (r < I_UP) { transpose_item(w_up, DM, DFF, g_mlp, g_mlp, DM, WUPT, scr, r, lane); continue; } r -= I_UP;
            transpose_item(w_down, DFF, DM, nullptr, nullptr, 0, WDOWNT, scr, r, lane);
        }
        for (int r = gw; r < SEQ; r += ngw) rms_row_bf16(x + (size_t)r * DM, H0 + (size_t)r * DM, lane);
        { const int gi = blockIdx.x * (NWAVES * 64) + tid; if (gi < NG * NP) ssm_params(gi, a_re, a_im, b_re, b_im, log_dt, PA, PA64, PBB); }
    }
    SEAM(0);
    if (IN(1)) GEMM_PHASE(pg8::EpiB<0>, H0, WINT, SEQ, INW, DM, ZB, INW, 0);
    SEAM(1);
    if (IN(2)) {
        for (int item = gw; item < NG * NCH; item += ngw) ssm_pass1_item(item, lane, ZB, PA, PBB, E);
        for (int r = gw; r < SEQ; r += ngw) sgu_ln_row(r, lane, ZB, ln_g, ln_b, VLN);
    }
    SEAM(2);
    if (IN(3)) {
        { const int gi = blockIdx.x * (NWAVES * 64) + tid; if (gi < NG * NP) ssm_carry(gi, PA64, E, XIN); }
        for (int it = blockIdx.x; it < SEQ * 2; it += gridDim.x) sgu_mix_item(it, tid, ZB, VLN, sgu_w, sgu_b, YSGU);
    }
    SEAM(3);
    if (IN(4)) {
        LAS float* sm = (LAS float*)(L + RING_OFF + wave * 4352);
        for (int base = blockIdx.x * NWAVES; base < NG * NCH; base += gridDim.x * NWAVES) ssm_pass3_item(base + wave, lane, sm, ZB, PA, PBB, XIN, c_re, c_im, ssm_d, YACT);
    }
    SEAM(4);
    if (IN(5)) GEMM_PHASE(pg8::EpiF32, YACT, GLUT, SEQ, SSMW, SSMW, GLUC, nullptr, SSMW, 0);
    SEAM(5);
    if (IN(6)) { for (int r = gw; r < SEQ; r += ngw) outnorm_row(r, lane, YACT, GLUC, glu_b, YSGU, AOUT); }
    SEAM(6);
    if (IN(7)) GEMM_PHASE(pg8::EpiF32, AOUT, WOUTT, SEQ, DM, DM, out, x, DM, 0);
    SEAM(7);
    if (IN(8)) { for (int r = gw; r < SEQ; r += ngw) rms_row_bf16(out + (size_t)r * DM, AMLP + (size_t)r * DM, lane); }
    SEAM(8);
    if (IN(9)) GEMM_PHASE(pg8::EpiB<2>, AMLP, WUPT, SEQ, DFF, DM, H, DFF, 0);
    SEAM(9);
    if (IN(10)) GEMM_PHASE(pg8::EpiF32, H, WDOWNT, SEQ, DM, DFF, out, out, DM, 0);
    SEAM(10);
    if (IN(11)) { for (int r = gw; r < SEQ; r += ngw) final_rms_row(out + (size_t)r * DM, g_fin, lane); }
#undef IN
#undef SEAM
}

extern "C" void kernel_launch(void* const* d_in, const int* in_sizes, int n_in, void* d_out, int out_size, void* d_ws, size_t ws_size, hipStream_t stream) {
    static int grid = 0;
    if (grid == 0) {
        if (n_in != 24 || ws_size < WS_END) { fprintf(stderr, "kernel_launch: unexpected n_in %d / ws %zu\n", n_in, ws_size); grid = -1; return; }
        int dev = 0, cus = 0, per_cu = 0;
        if (hipGetDevice(&dev) != hipSuccess || hipDeviceGetAttribute(&cus, hipDeviceAttributeMultiprocessorCount, dev) != hipSuccess) { grid = -1; return; }
        if (hipFuncSetAttribute((const void*)fwd, hipFuncAttributeMaxDynamicSharedMemorySize, LDS_BYTES) != hipSuccess) { fprintf(stderr, "kernel_launch: hipFuncSetAttribute failed\n"); grid = -1; return; }
        if (hipOccupancyMaxActiveBlocksPerMultiprocessor(&per_cu, (const void*)fwd, NWAVES * 64, LDS_BYTES) != hipSuccess || per_cu < 1) { fprintf(stderr, "kernel_launch: occupancy query says %d blocks per CU\n", per_cu); }
        (void)hipGetLastError();
        grid = cus;
    }
    if (grid < 0) return;
    (void)hipMemsetAsync((char*)d_ws + WS_CTL, 0, CTL_ZERO_BYTES, stream);
    Args a{};
    for (int i = 0; i < 24; ++i) a.in[i] = (const float*)d_in[i];
    a.out = (float*)d_out; a.ws = (unsigned char*)d_ws;
    if (N_LAUNCHES == 1) { a.ph_lo = 0; a.ph_hi = PER_PHASE; hipLaunchKernelGGL(fwd, dim3(grid), dim3(NWAVES * 64), LDS_BYTES, stream, a); }
    else { for (int p = 0; p < PER_PHASE; ++p) { a.ph_lo = p; a.ph_hi = p + 1; hipLaunchKernelGGL(fwd, dim3(grid), dim3(NWAVES * 64), LDS_BYTES, stream, a); } }
}
```

```cpp
#include <hip/hip_runtime.h>
#include <cstdio>
#include <cstdint>
namespace pg8 {
#define PG8_LAS __attribute__((address_space(3)))
typedef unsigned short bf16_t;
typedef short bf16x8 __attribute__((ext_vector_type(8)));
typedef float f32x4 __attribute__((ext_vector_type(4)));
typedef unsigned u32x4 __attribute__((ext_vector_type(4)));
constexpr int BM = 256, BK = 64, HALF = 128, HTB = HALF * BK * 2  , STAGE_BYTES = 8 * HTB, NXCD = 8, WGM = 8;

__host__ __device__ __forceinline__ int lds_byte(int r, int c) { const int st = (r >> 4) * 2 + (c >> 5), rr = r & 15, cc = c & 31, ob = rr * 64 + cc * 2; return st * 1024 + (ob ^ (((ob >> 9) & 1) << 5)); }
__host__ __device__ __forceinline__ void stage_rc(int b, int& R, int& C) { const int st = b / 1024, sb = b % 1024, swz = sb ^ (((sb >> 9) & 1) << 5); R = (st >> 1) * 16 + swz / 64; C = (st & 1) * 32 + (swz % 64) / 2; }
__host__ __device__ __forceinline__ int perm32(int rho) { const int n = rho >> 4, i = rho & 15; return 8 * (i >> 2) + 4 * n + (i & 3); }

struct Unit { int pm, pn; };
struct Gemm { const bf16_t* A; const bf16_t* Bt; int M, N, K; };

struct StaticOrder {
    int nM, nN, nwg, G, c;
    __host__ __device__ void init(int M, int N, int G_, int c_) { nM = M / BM; nN = N / BM; nwg = nM * nN; G = G_; c = c_; }
    __host__ __device__ bool next(int i, Unit& u) const {
        const long L = (long)i * G + c; if (L >= nwg) return false;
        int wgid = (int)L; { const int q = nwg / NXCD, r = nwg % NXCD, xcd = wgid % NXCD, off = wgid / NXCD; wgid = (xcd < r ? xcd * (q + 1) : r * (q + 1) + (xcd - r) * q) + off; }
        const int nig = WGM * nN, gid = wgid / nig, fm = gid * WGM, gsz = (nM - fm) < WGM ? (nM - fm) : WGM;
        u.pm = fm + ((wgid % nig) % gsz); u.pn = (wgid % nig) / gsz; return true;
    }
    __device__ __forceinline__ void a_ready(const Unit&) const {}
    __device__ __forceinline__ void done(const Unit&) const {}
};

__device__ __forceinline__ unsigned cvt_pk_bf16(float lo, float hi) { unsigned r; asm volatile("v_cvt_pk_bf16_f32 %0, %1, %2" : "=v"(r) : "v"(lo), "v"(hi)); return r; }
typedef float f32x2 __attribute__((ext_vector_type(2)));
}
namespace gp {
using namespace pg8;
struct Unit { const char* a; const char* b; int pm, pn, nt, kind; };
template <class Epi, class Sched, bool ALIGN_EPI = false, bool SP2 = false>
__device__ __forceinline__ void gemm_phase(PG8_LAS unsigned char* lds, const int ld  , const Sched& S, const Epi& E) {
    const int tid = threadIdx.x, wid = __builtin_amdgcn_readfirstlane(tid >> 6), lane = tid & 63, wr = wid >> 2, wc = wid & 3, fr = lane & 15, fq = lane >> 4;
    unsigned voffA[2], voffB[2];
#pragma unroll
    for (int i = 0; i < 2; ++i) { int R, C; stage_rc(tid * 16 + i * 8192, R, C); const int Rb = Epi::PERM ? ((R & ~31) + perm32(R & 31)) : R;
        voffA[i] = (unsigned)(R * ld + C * 2); voffB[i] = (unsigned)(Rb * ld + C * 2); }
    const size_t kstep = (size_t)(BK * 2);
    const size_t hstep = (size_t)HALF * ld;
    const unsigned ldsw = (unsigned)wid * 1024u;
    const int aoff = lds_byte(wr * 64 + fr, fq * 8), boff = lds_byte(wc * 32 + fr, fq * 8);
#define PG8_SA(b, h) (((b) * 2 + (h)) * HTB)
#define PG8_SB(b, h) ((4 + (b) * 2 + (h)) * HTB)
#define PG8_STAGE(bufoff, gbase, voff) do { _Pragma("unroll") for (int _i = 0; _i < 2; ++_i) \
        __builtin_amdgcn_global_load_lds((const unsigned*)((const char*)(gbase) + (voff)[_i]), (PG8_LAS unsigned*)(lds + (bufoff) + ldsw + _i * 8192), 16, 0, 0); } while (0)
#define PG8_LDA(dst, b, h) do { _Pragma("unroll") for (int m = 0; m < 4; ++m) _Pragma("unroll") for (int k = 0; k < 2; ++k) dst[m][k] = *(const PG8_LAS bf16x8*)(lds + PG8_SA(b, h) + aoff + m * 2048 + k * 1024); } while (0)
#define PG8_LDB(dst, b, h) do { _Pragma("unroll") for (int n = 0; n < 2; ++n) _Pragma("unroll") for (int k = 0; k < 2; ++k) dst[n][k] = *(const PG8_LAS bf16x8*)(lds + PG8_SB(b, h) + boff + n * 2048 + k * 1024); } while (0)
#define PG8_MMA(ai, bj, At, Bt) do { __builtin_amdgcn_s_setprio(1); _Pragma("unroll") for (int m = 0; m < 4; ++m) _Pragma("unroll") for (int n = 0; n < 2; ++n) _Pragma("unroll") for (int k = 0; k < 2; ++k) \
        acc[ai][bj][m][n] = __builtin_amdgcn_mfma_f32_16x16x32_bf16(Bt[n][k], At[m][k], acc[ai][bj][m][n], 0, 0, 0); __builtin_amdgcn_s_setprio(0); } while (0)
#define PG8_WAIT_V(n) asm volatile("s_waitcnt vmcnt(" #n ")" ::: "memory")
#define PG8_WAIT_L(n) asm volatile("s_waitcnt lgkmcnt(" #n ")" ::: "memory")
#define PG8_BAR __builtin_amdgcn_s_barrier()
#define PG8_SCHED __builtin_amdgcn_sched_barrier(0)
    Unit cur, nxt; int ui = 0;
    if (!S.next(0, cur)) return;
    f32x4 acc[2][2][4][2];
#pragma unroll
    for (int a = 0; a < 2; ++a)
#pragma unroll
        for (int b = 0; b < 2; ++b)
#pragma unroll
            for (int m = 0; m < 4; ++m)
#pragma unroll
                for (int n = 0; n < 2; ++n) acc[a][b][m][n] = (f32x4){0.f, 0.f, 0.f, 0.f};
    bf16x8 At[4][2], B0[2][2], B1[2][2];
    const char* cA = cur.a; const char* cB = cur.b;
    if constexpr (SP2) {
        PG8_STAGE(PG8_SB(0, 0), cB, voffB); PG8_STAGE(PG8_SB(0, 1), cB + hstep, voffB); PG8_STAGE(PG8_SA(0, 0), cA, voffA); PG8_STAGE(PG8_SA(0, 1), cA + hstep, voffA);
        if (wr == 1) PG8_BAR;
        PG8_WAIT_V(2); PG8_BAR;
        PG8_STAGE(PG8_SB(1, 0), cB + kstep, voffB); PG8_STAGE(PG8_SA(1, 0), cA + kstep, voffA); PG8_STAGE(PG8_SB(1, 1), cB + hstep + kstep, voffB);
        PG8_WAIT_V(6); PG8_BAR;
    } else {
        PG8_STAGE(PG8_SB(0, 0), cB, voffB); PG8_STAGE(PG8_SA(0, 0), cA, voffA); PG8_STAGE(PG8_SB(0, 1), cB + hstep, voffB); PG8_STAGE(PG8_SA(0, 1), cA + hstep, voffA);
        if (wr == 1) PG8_BAR;
        PG8_WAIT_V(4); PG8_BAR;
        PG8_STAGE(PG8_SB(1, 0), cB + kstep, voffB); PG8_STAGE(PG8_SA(1, 0), cA + kstep, voffA); PG8_STAGE(PG8_SB(1, 1), cB + hstep + kstep, voffB);
        PG8_WAIT_V(6); PG8_BAR;
    }
    for (;;) {
        const bool has_next = S.next(ui + 1, nxt);
        const char* nA = has_next ? nxt.a : cA; const char* nB = has_next ? nxt.b : cB;
        const int nt = cur.nt;
        for (int t = 0; t < nt; t += 2) {
            const bool last = (t == nt - 2);
            const char* a1 = cA + (size_t)(t + 1) * kstep;
            const char* a2 = last ? nA : cA + (size_t)(t + 2) * kstep; const char* b2 = last ? nB : cB + (size_t)(t + 2) * kstep;
            const char* a3 = a2 + kstep; const char* b3 = b2 + kstep;
            if constexpr (SP2) {
            PG8_LDB(B0, 0, 0); PG8_LDB(B1, 0, 1); PG8_SCHED; PG8_LDA(At, 0, 0); PG8_STAGE(PG8_SA(1, 1), a1 + hstep, voffA);
            PG8_WAIT_V(8); PG8_WAIT_L(0); PG8_BAR; PG8_MMA(0, 0, At, B0); PG8_MMA(0, 1, At, B1); PG8_BAR; PG8_SCHED;
            PG8_LDA(At, 0, 1); PG8_STAGE(PG8_SB(0, 0), b2, voffB); PG8_STAGE(PG8_SB(0, 1), b2 + hstep, voffB); PG8_STAGE(PG8_SA(0, 0), a2, voffA);
            PG8_WAIT_V(8); PG8_WAIT_L(0); PG8_BAR; PG8_MMA(1, 0, At, B0); PG8_MMA(1, 1, At, B1); PG8_BAR; PG8_SCHED;
            PG8_LDB(B0, 1, 0); PG8_LDB(B1, 1, 1); PG8_SCHED; PG8_LDA(At, 1, 0); PG8_STAGE(PG8_SA(0, 1), a2 + hstep, voffA);
            PG8_WAIT_V(8); PG8_WAIT_L(0); PG8_BAR; PG8_MMA(0, 0, At, B0); PG8_MMA(0, 1, At, B1); PG8_BAR; PG8_SCHED;
            PG8_LDA(At, 1, 1); PG8_STAGE(PG8_SB(1, 0), b3, voffB); PG8_STAGE(PG8_SB(1, 1), b3 + hstep, voffB); PG8_STAGE(PG8_SA(1, 0), a3, voffA);
            PG8_WAIT_V(8); PG8_WAIT_L(0); PG8_BAR; PG8_MMA(1, 0, At, B0); PG8_MMA(1, 1, At, B1); PG8_BAR; PG8_SCHED;
            } else {
            PG8_LDB(B0, 0, 0); PG8_SCHED; PG8_LDA(At, 0, 0); PG8_STAGE(PG8_SA(1, 1), a1 + hstep, voffA);
            PG8_WAIT_L(8); PG8_BAR; PG8_WAIT_L(0); PG8_MMA(0, 0, At, B0); PG8_BAR; PG8_SCHED;
            PG8_LDB(B1, 0, 1); PG8_STAGE(PG8_SB(0, 0), b2, voffB);
            PG8_BAR; PG8_WAIT_L(0); PG8_MMA(0, 1, At, B1); PG8_BAR;
            PG8_LDA(At, 0, 1); PG8_STAGE(PG8_SA(0, 0), a2, voffA);
            PG8_BAR; PG8_WAIT_L(0); PG8_MMA(1, 0, At, B0); PG8_BAR; PG8_SCHED;
            PG8_STAGE(PG8_SB(0, 1), b2 + hstep, voffB);
            PG8_WAIT_V(6); PG8_BAR; PG8_MMA(1, 1, At, B1); PG8_BAR;
            PG8_LDB(B0, 1, 0); PG8_SCHED; PG8_LDA(At, 1, 0); PG8_STAGE(PG8_SA(0, 1), a2 + hstep, voffA);
            PG8_WAIT_L(8); PG8_BAR; PG8_WAIT_L(0); PG8_MMA(0, 0, At, B0); PG8_BAR; PG8_SCHED;
            PG8_LDB(B1, 1, 1); PG8_STAGE(PG8_SB(1, 0), b3, voffB);
            PG8_BAR; PG8_WAIT_L(0); PG8_MMA(0, 1, At, B1); PG8_BAR;
            PG8_LDA(At, 1, 1); PG8_STAGE(PG8_SA(1, 0), a3, voffA);
            PG8_BAR; PG8_WAIT_L(0); PG8_MMA(1, 0, At, B0); PG8_BAR; PG8_SCHED;
            PG8_STAGE(PG8_SB(1, 1), b3 + hstep, voffB);
            PG8_WAIT_V(6); PG8_BAR; PG8_MMA(1, 1, At, B1); PG8_BAR;
            }
        }
        if constexpr (ALIGN_EPI) { if (wr == 0) PG8_BAR; }
        const bool keep = E(acc, cur, wr, wc, fr, fq);
        if (!has_next) break;
        if (!keep)
#pragma unroll
        for (int a = 0; a < 2; ++a)
#pragma unroll
            for (int b = 0; b < 2; ++b)
#pragma unroll
                for (int m = 0; m < 4; ++m)
#pragma unroll
                    for (int n = 0; n < 2; ++n) acc[a][b][m][n] = (f32x4){0.f, 0.f, 0.f, 0.f};
        cur = nxt; cA = nA; cB = nB; ++ui;
        if constexpr (ALIGN_EPI) { if (wr == 1) PG8_BAR; }
    }
    PG8_WAIT_V(0);
    if constexpr (!ALIGN_EPI) { if (wr == 0) PG8_BAR; }
    PG8_BAR;
#undef PG8_SA
#undef PG8_SB
#undef PG8_STAGE
#undef PG8_LDA
#undef PG8_LDB
#undef PG8_MMA
#undef PG8_WAIT_V
#undef PG8_WAIT_L
#undef PG8_BAR
#undef PG8_SCHED
}
struct StdSched { StaticOrder so; const char* A; const char* B; int ld, nt;
    __device__ __forceinline__ void init(const void* A_, const void* B_, int M, int N, int K, int G, int c) { so.init(M, N, G, c); A = (const char*)A_; B = (const char*)B_; ld = K * 2; nt = K / BK; }
    __device__ __forceinline__ bool next(int i, Unit& u) const { pg8::Unit q; if (!so.next(i, q)) return false; u.pm = q.pm; u.pn = q.pn; u.a = A + (size_t)q.pm * BM * ld; u.b = B + (size_t)q.pn * BM * ld; u.nt = nt; u.kind = 0; return true; }
};
typedef f32x4 Acc[2][2][4][2];
struct EpiZ {
    static constexpr bool PERM = true; bf16_t* O; int ldc;
    __device__ __forceinline__ bool operator()(Acc& acc, const Unit& u, int wr, int wc, int fr, int fq) const {
        const int row0 = u.pm * BM + wr * 64 + fr, col0 = u.pn * BM + wc * 32 + 8 * fq;
#pragma unroll
        for (int ai = 0; ai < 2; ++ai)
#pragma unroll
            for (int m = 0; m < 4; ++m) { bf16_t* rowp = O + (size_t)(row0 + ai * HALF + m * 16) * ldc + col0;
#pragma unroll
                for (int bj = 0; bj < 2; ++bj) { const f32x4 v0 = acc[ai][bj][m][0], v1 = acc[ai][bj][m][1];
                    u32x4 w; w.x = cvt_pk_bf16(v0[0], v0[1]); w.y = cvt_pk_bf16(v0[2], v0[3]); w.z = cvt_pk_bf16(v1[0], v1[1]); w.w = cvt_pk_bf16(v1[2], v1[3]);
                    *(u32x4*)(rowp + bj * HALF) = w; } }
        return false;
    }
};
struct EpiF32 {
    static constexpr bool PERM = true; float* out; int ldc;
    __device__ __forceinline__ bool operator()(Acc& acc, const Unit& u, int wr, int wc, int fr, int fq) const {
        const int row0 = u.pm * BM + wr * 64 + fr, col0 = u.pn * BM + wc * 32 + 8 * fq;
#pragma unroll
        for (int ai = 0; ai < 2; ++ai)
#pragma unroll
            for (int m = 0; m < 4; ++m) { float* rowp = out + (size_t)(row0 + ai * HALF + m * 16) * ldc + col0;
#pragma unroll
                for (int bj = 0; bj < 2; ++bj) { *(f32x4*)(rowp + bj * HALF) = acc[ai][bj][m][0]; *(f32x4*)(rowp + bj * HALF + 4) = acc[ai][bj][m][1]; } }
        return false;
    }
};
struct EpiRes {
    static constexpr bool PERM = true; const float* base; float* out; bf16_t* abf; float* ss; int ldc;
    __device__ __forceinline__ bool operator()(Acc& acc, const Unit& u, int wr, int wc, int fr, int fq) const {
        const int row0 = u.pm * BM + wr * 64 + fr, col0 = u.pn * BM + wc * 32 + 8 * fq;
#pragma unroll
        for (int ai = 0; ai < 2; ++ai)
#pragma unroll
            for (int m = 0; m < 4; ++m) { const int row = row0 + ai * HALF + m * 16; const size_t off = (size_t)row * ldc + col0; float rs = 0.f;
#pragma unroll
                for (int bj = 0; bj < 2; ++bj) { const f32x4 v0 = acc[ai][bj][m][0] + *(const f32x4*)(base + off + bj * HALF), v1 = acc[ai][bj][m][1] + *(const f32x4*)(base + off + bj * HALF + 4);
                    *(f32x4*)(out + off + bj * HALF) = v0; *(f32x4*)(out + off + bj * HALF + 4) = v1;
                    rs += (v0[0] * v0[0] + v0[1] * v0[1]) + (v0[2] * v0[2] + v0[3] * v0[3]) + (v1[0] * v1[0] + v1[1] * v1[1]) + (v1[2] * v1[2] + v1[3] * v1[3]);
                    if (abf) { u32x4 w; w.x = cvt_pk_bf16(v0[0], v0[1]); w.y = cvt_pk_bf16(v0[2], v0[3]); w.z = cvt_pk_bf16(v1[0], v1[1]); w.w = cvt_pk_bf16(v1[2], v1[3]); *(u32x4*)(abf + off + bj * HALF) = w; } }
                rs += __shfl_xor(rs, 16); rs += __shfl_xor(rs, 32);
                if (fq == 0) (void)__hip_atomic_fetch_add(ss + row, rs, __ATOMIC_RELAXED, __HIP_MEMORY_SCOPE_AGENT); }
        return false;
    }
};
struct EpiH {
    static constexpr bool PERM = true; bf16_t* O; const float* ss; int ldc; float inv_n, eps;
    __device__ __forceinline__ bool operator()(Acc& acc, const Unit& u, int wr, int wc, int fr, int fq) const {
        const int row0 = u.pm * BM + wr * 64 + fr, col0 = u.pn * BM + wc * 32 + 8 * fq;
#pragma unroll
        for (int ai = 0; ai < 2; ++ai)
#pragma unroll
            for (int m = 0; m < 4; ++m) { const int row = row0 + ai * HALF + m * 16; bf16_t* rowp = O + (size_t)row * ldc + col0;
                const float r2 = 1.0f / (ss[row] * inv_n + eps);
#pragma unroll
                for (int bj = 0; bj < 2; ++bj) { f32x4 v0 = acc[ai][bj][m][0], v1 = acc[ai][bj][m][1];
#pragma unroll
                    for (int e = 0; e < 4; ++e) { const float a = fmaxf(v0[e], 0.f), b = fmaxf(v1[e], 0.f); v0[e] = a * a * r2; v1[e] = b * b * r2; }
                    u32x4 w; w.x = cvt_pk_bf16(v0[0], v0[1]); w.y = cvt_pk_bf16(v0[2], v0[3]); w.z = cvt_pk_bf16(v1[0], v1[1]); w.w = cvt_pk_bf16(v1[2], v1[3]);
                    *(u32x4*)(rowp + bj * HALF) = w; } }
        return false;
    }
};
}
constexpr int SEQ = 8192, DM = 2048, SSMW = 1024, SGUW = 1024, INW = 3072, DFF = 8192;
constexpr int NG = 64, NP = 64, NHG = 16, SGH = 8, SGD = 128, SGC = 128;
constexpr float EPS = 1e-6f;
typedef unsigned short bf16;
typedef unsigned v4u __attribute__((ext_vector_type(4)));
typedef float f32x4 __attribute__((ext_vector_type(4)));
#define LAS __attribute__((address_space(3)))

__device__ __forceinline__ unsigned f2bf(float f) { unsigned u = __builtin_bit_cast(unsigned, f); return (u + 0x7fffu + ((u >> 16) & 1u)) >> 16; }
__device__ __forceinline__ unsigned pk2(float lo, float hi) { return f2bf(lo) | (f2bf(hi) << 16); }
__device__ __forceinline__ float bf2f(unsigned short b) { return __builtin_bit_cast(float, (unsigned)b << 16); }
__device__ __forceinline__ float bflo(unsigned w) { return __builtin_bit_cast(float, w << 16); }
__device__ __forceinline__ float bfhi(unsigned w) { return __builtin_bit_cast(float, w & 0xffff0000u); }
__device__ __forceinline__ float wave_sum(float v) {
#pragma unroll
    for (int o = 1; o < 64; o <<= 1) v += __shfl_xor(v, o);
    return v;
}
__device__ __forceinline__ float gelu_tanh(float x) { return 0.5f * x * (1.0f + tanhf(0.7978845608028654f * (x + 0.044715f * x * x * x))); }

__device__ __forceinline__ float gelu_fast(float x) { const float u = x * (1.5957691216057308f + 0.0713548162726009f * x * x); return x / (1.0f + __expf(-u)); }
#define XB_TMO      128
#define XB_XCNT(j)  (256  + 64 * (j))
#define XB_XSUB(j)  (1280 + 64 * (j))
#define XB_XGEN(j)  (2304 + 64 * (j))
#define XB_TOP      3328
#define XB_TOPGEN   3392
#define XCD_BAR_WORDS 3456
#define XB_SPIN_CAP (1u << 18)

__device__ __forceinline__ unsigned xb_ld(unsigned* p)              { return __hip_atomic_load(p, __ATOMIC_RELAXED, __HIP_MEMORY_SCOPE_AGENT); }
__device__ __forceinline__ unsigned xb_add(unsigned* p, unsigned v) { return __hip_atomic_fetch_add(p, v, __ATOMIC_RELAXED, __HIP_MEMORY_SCOPE_AGENT); }
__device__ __forceinline__ unsigned xb_xcc_id() { return (unsigned)__builtin_amdgcn_s_getreg((3 << 11) | 20) & 0xFu; }
#define XB_SPIN(cond, bar) do { unsigned _sp = 0; while (cond) { __builtin_amdgcn_s_sleep(1); \
    if ((++_sp & 255u) == 0u) { if (xb_ld(&(bar)[XB_TMO])) break; if (_sp > XB_SPIN_CAP) { atomicAdd(&(bar)[XB_TMO], 1u); break; } } } } while (0)

struct XcdBarrier {
    unsigned* bar; unsigned x;
    volatile LAS unsigned* st;
};

__device__ __forceinline__ XcdBarrier xcd_barrier_post(unsigned* bar, volatile LAS unsigned* st) {
    XcdBarrier b; b.bar = bar; b.x = xb_xcc_id(); b.st = st;
    if (threadIdx.x == 0) (void)xb_add(&bar[XB_XCNT(b.x)], 1u);
    return b;
}
__device__ __forceinline__ void xcd_barrier_complete(unsigned* bar, unsigned x, unsigned& nloc, unsigned& nx) {
    const unsigned G = gridDim.x * gridDim.y * gridDim.z;
    unsigned sum, cnt, mine, sp = 0u;
    for (;;) {
        sum = 0u; cnt = 0u; mine = 0u;
#pragma unroll
        for (unsigned j = 0; j < 16; ++j) { const unsigned c = xb_ld(&bar[XB_XCNT(j)]); sum += c; cnt += (c > 0u) ? 1u : 0u; mine = (j == x) ? c : mine; }
        if (sum == G) break;
        __builtin_amdgcn_s_sleep(1);
        if ((++sp & 255u) == 0u) { if (xb_ld(&bar[XB_TMO])) break; if (sp > XB_SPIN_CAP) { atomicAdd(&bar[XB_TMO], 1u); break; } }
    }
    nloc = mine > 0u ? mine : 1u; nx = cnt > 0u ? cnt : 1u;
}

__device__ __forceinline__ void xcd_barrier(const XcdBarrier& b) {
    asm volatile("s_waitcnt vmcnt(0)" ::: "memory");
    __syncthreads();
    if (threadIdx.x == 0) {
        unsigned* bar = b.bar;
        __builtin_amdgcn_s_waitcnt(0);
        unsigned nloc = b.st[0], nx = b.st[1];
        if (nloc == 0u) { xcd_barrier_complete(bar, b.x, nloc, nx); b.st[0] = nloc; b.st[1] = nx; }
        const unsigned old = xb_add(&bar[XB_XSUB(b.x)], 1u);
        const unsigned gen = old / nloc;
        if (old + 1u == (gen + 1u) * nloc) {
            __builtin_amdgcn_fence(__ATOMIC_RELEASE, "agent");
            asm volatile("s_waitcnt vmcnt(0)" ::: "memory");
            const unsigned og = xb_add(&bar[XB_TOP], 1u);
            const unsigned tg = og / nx;
            if (og + 1u == (tg + 1u) * nx) xb_add(&bar[XB_TOPGEN], 1u);
            else XB_SPIN(xb_ld(&bar[XB_TOPGEN]) == tg, bar);
            __builtin_amdgcn_fence(__ATOMIC_ACQUIRE, "agent");
            xb_add(&bar[XB_XGEN(b.x)], 1u);
            asm volatile("s_waitcnt vmcnt(0)" ::: "memory");
        } else {
            XB_SPIN(xb_ld(&bar[XB_XGEN(b.x)]) == gen, bar);
            __builtin_amdgcn_fence(__ATOMIC_ACQUIRE, "agent");
            asm volatile("s_waitcnt vmcnt(0)" ::: "memory");
        }
    }
    __syncthreads();
}
constexpr size_t MiB = 1u << 20;
constexpr size_t WS_CTL = 0, CTL_ZERO_BYTES = 64 * 1024;
constexpr size_t WS_WUPT = 1 * MiB, WS_WDOWNT = 33 * MiB, WS_AMLP = 65 * MiB, WS_H = 97 * MiB;
constexpr size_t WS_WINT = 65 * MiB, WS_VT = 77 * MiB;
constexpr size_t WS_GLUT = 97 * MiB, WS_WOUTT = 99 * MiB, WS_H0 = 107 * MiB, WS_ASSM = 139 * MiB, WS_UACT = 159 * MiB, WS_YACT = 175 * MiB, WS_TTAB = 191 * MiB, WS_PTAB = 231 * MiB, WS_A32 = 239 * MiB;
constexpr size_t WS_AOUT = WS_H0, WS_END = 256 * MiB;
constexpr size_t WS_STAT = 256 * 1024;
constexpr int CW_BAR = 4096;
constexpr int RING_OFF = 0, RING_BYTES = 131072;
constexpr int MISC_OFF = RING_BYTES + 320;
constexpr int LDS_BYTES = 147456;
constexpr int NWAVES = 8;
typedef __attribute__((address_space(1))) unsigned gu32;
#define RLX_AGENT __ATOMIC_RELAXED, __HIP_MEMORY_SCOPE_AGENT

struct Ctx { LAS unsigned char* lds; int tid, lane, wave, gw, ngw; };

__device__ __forceinline__ void transpose_item(const float* W, int K, int N, const float* s0, const float* s1, int split, bf16* WT, LAS float* scr, int item, int lane) {
    const int nblk = N / 32, kb = item / nblk, nb = item % nblk, k0 = 64 * kb, n0 = 32 * nb;
#pragma unroll 8
    for (int i = 0; i < 32; ++i) { const int kk = 2 * i + (lane >> 5); const int k = k0 + kk;
        float sc = 1.0f; if (s0) sc = (k < split) ? s0[k] : s1[k - split];
        scr[kk * 33 + (lane & 31)] = W[(size_t)k * N + n0 + (lane & 31)] * sc; }
    asm volatile("s_waitcnt lgkmcnt(0)" ::: "memory");
    const int c = lane & 7;
#pragma unroll
    for (int j = 0; j < 4; ++j) { const int n = (lane >> 3) + 8 * j; const LAS float* s = scr + (8 * c) * 33 + n;
        v4u o; o.x = pk2(s[0 * 33], s[1 * 33]); o.y = pk2(s[2 * 33], s[3 * 33]); o.z = pk2(s[4 * 33], s[5 * 33]); o.w = pk2(s[6 * 33], s[7 * 33]);
        *(v4u*)(WT + (size_t)(n0 + n) * K + k0 + 8 * c) = o; }
    asm volatile("s_waitcnt lgkmcnt(0)" ::: "memory");
}
__device__ __forceinline__ void rms_row_bf16(const float* xrow, bf16* orow, int lane) {
    const f32x4* xr = (const f32x4*)xrow + lane; f32x4 v[8]; float ss = 0.f;
#pragma unroll
    for (int j = 0; j < 8; ++j) { v[j] = xr[64 * j]; ss += (v[j].x * v[j].x + v[j].y * v[j].y) + (v[j].z * v[j].z + v[j].w * v[j].w); }
    const float rs = 1.0f / sqrtf(wave_sum(ss) * (1.0f / DM) + EPS);
    unsigned long long* o8 = (unsigned long long*)orow + lane;
#pragma unroll
    for (int j = 0; j < 8; ++j) o8[64 * j] = (unsigned long long)pk2(v[j].x * rs, v[j].y * rs) | ((unsigned long long)pk2(v[j].z * rs, v[j].w * rs) << 32);
}
__device__ __forceinline__ void final_rms_row(float* xrow, const float* g, int lane) {
    f32x4* xr = (f32x4*)xrow + lane; const f32x4* gr = (const f32x4*)g + lane; f32x4 v[8]; float ss = 0.f;
#pragma unroll
    for (int j = 0; j < 8; ++j) { v[j] = xr[64 * j]; ss += (v[j].x * v[j].x + v[j].y * v[j].y) + (v[j].z * v[j].z + v[j].w * v[j].w); }
    const float rs = 1.0f / sqrtf(wave_sum(ss) * (1.0f / DM) + EPS);
#pragma unroll
    for (int j = 0; j < 8; ++j) xr[64 * j] = v[j] * rs * gr[64 * j];
}
constexpr int SL = 32, SNC = SEQ / SL, SK = 128 + SL * 16;
typedef short bf16x8v __attribute__((ext_vector_type(8)));
typedef float f32x16 __attribute__((ext_vector_type(16)));
constexpr int TB_APOW = 0, TB_BB = 33 * 64 * 8, TB_CC = TB_BB + 64 * 16 * 8, TB_KT = TB_CC + 16 * 64 * 8, TB_END = TB_KT + 32 * 256 * 4;
__device__ __forceinline__ void ssm_build_tables(LAS unsigned char* L, int g, int tid, const float* a_re, const float* a_im, const float* b_re, const float* b_im,
                                                 const float* c_re, const float* c_im, const float* log_dt, bf16* TTAB, bf16* PTAB, float* A32) {
    LAS float* apow = (LAS float*)(L + TB_APOW); LAS float* Bb = (LAS float*)(L + TB_BB); LAS float* Cc = (LAS float*)(L + TB_CC); LAS float* Kt = (LAS float*)(L + TB_KT);
    if (tid < NP) { const int p = tid, i = g * NP + p;
        const double dt = exp((double)log_dt[g]); const double lr = a_re[i], li = a_im[i];
        const double zr = lr * dt, zi = li * dt, ea = exp(zr); const double ar = ea * cos(zi), ai = ea * sin(zi);
        const double d2 = lr * lr + li * li; const double qr = ((ar - 1.0) * lr + ai * li) / d2, qi = (ai * lr - (ar - 1.0) * li) / d2;
        for (int h = 0; h < NHG; ++h) { const double br = b_re[i * NHG + h], bi = b_im[i * NHG + h]; Bb[(p * 16 + h) * 2] = (float)(qr * br - qi * bi); Bb[(p * 16 + h) * 2 + 1] = (float)(qr * bi + qi * br); }
        double pr = 1.0, pi = 0.0;
        for (int k = 0; k <= SL; ++k) { apow[(k * 64 + p) * 2] = (float)pr; apow[(k * 64 + p) * 2 + 1] = (float)pi; const double nr = pr * ar - pi * ai, ni = pr * ai + pi * ar; pr = nr; pi = ni; }
        A32[i * 2] = apow[(SL * 64 + p) * 2]; A32[i * 2 + 1] = apow[(SL * 64 + p) * 2 + 1];
    }
    for (int e = tid; e < 16 * 64; e += 512) { Cc[e * 2] = c_re[g * 1024 + e]; Cc[e * 2 + 1] = c_im[g * 1024 + e]; }
    __syncthreads();
    for (int e = tid; e < 32 * 256; e += 512) { const int tau = e >> 8, h = (e >> 4) & 15, hp = e & 15; float s = 0.f;
        for (int p = 0; p < 64; ++p) { const float cr = Cc[(h * 64 + p) * 2], ci = Cc[(h * 64 + p) * 2 + 1], ar = apow[(tau * 64 + p) * 2], ai = apow[(tau * 64 + p) * 2 + 1], br = Bb[(p * 16 + hp) * 2], bi = Bb[(p * 16 + hp) * 2 + 1];
            const float wr = cr * ar - ci * ai, wi = cr * ai + ci * ar; s += wr * br - wi * bi; }
        Kt[e] = s; }
    __syncthreads();
    for (int idx = tid; idx < 512 * (SK / 8); idx += 512) { const int m = idx / (SK / 8), k0 = (idx % (SK / 8)) * 8, t = m >> 4, h = m & 15; float v[8];
        if (k0 < 128) { const int p0 = k0 & 63; const bool im = k0 >= 64;
#pragma unroll
            for (int j = 0; j < 8; ++j) { const int p = p0 + j; const float cr = Cc[(h * 64 + p) * 2], ci = Cc[(h * 64 + p) * 2 + 1], ar = apow[((t + 1) * 64 + p) * 2], ai = apow[((t + 1) * 64 + p) * 2 + 1];
                v[j] = im ? -(cr * ai + ci * ar) : (cr * ar - ci * ai); } }
        else { const int s = (k0 - 128) >> 4, hp0 = (k0 - 128) & 15;
#pragma unroll
            for (int j = 0; j < 8; ++j) v[j] = (s <= t) ? Kt[(t - s) * 256 + h * 16 + hp0 + j] : 0.f; }
        v4u o; o.x = pk2(v[0], v[1]); o.y = pk2(v[2], v[3]); o.z = pk2(v[4], v[5]); o.w = pk2(v[6], v[7]);
        *(v4u*)(TTAB + ((size_t)(g * 512 + m) * SK + k0)) = o; }
    for (int idx = tid; idx < 128 * 64; idx += 512) { const int pp = idx >> 6, k0 = (idx & 63) * 8, s = k0 >> 4, hp0 = k0 & 15, p = pp & 63; const bool im = pp >= 64; float v[8];
        const float ar = apow[((SL - 1 - s) * 64 + p) * 2], ai = apow[((SL - 1 - s) * 64 + p) * 2 + 1];
#pragma unroll
        for (int j = 0; j < 8; ++j) { const float br = Bb[(p * 16 + hp0 + j) * 2], bi = Bb[(p * 16 + hp0 + j) * 2 + 1]; v[j] = im ? (ar * bi + ai * br) : (ar * br - ai * bi); }
        v4u o; o.x = pk2(v[0], v[1]); o.y = pk2(v[2], v[3]); o.z = pk2(v[4], v[5]); o.w = pk2(v[6], v[7]);
        *(v4u*)(PTAB + ((size_t)(g * 128 + pp) * 512 + k0)) = o; }
    __syncthreads();
}
__device__ __forceinline__ void ssm_states(LAS unsigned char* L, int g, int lane, int wave, bf16* ASSM, const bf16* PTAB, const float* A32) {
    const int r32 = lane & 31, hi = lane >> 5;
    const bf16x8v* ap = (const bf16x8v*)(ASSM + (size_t)(g * SNC + 32 * wave + r32) * SK + 128 + 8 * hi);
    const bf16x8v* bp = (const bf16x8v*)(PTAB + (size_t)(g * 128 + r32) * 512 + 8 * hi);
    f32x16 acc[4];
#pragma unroll
    for (int b = 0; b < 4; ++b)
#pragma unroll
        for (int e = 0; e < 16; ++e) acc[b][e] = 0.f;
#pragma unroll 4
    for (int ks = 0; ks < 32; ++ks) { const bf16x8v a = ap[2 * ks];
#pragma unroll
        for (int b = 0; b < 4; ++b) { const bf16x8v bb = bp[(size_t)b * 32 * 512 / 8 + 2 * ks]; acc[b] = __builtin_amdgcn_mfma_f32_32x32x16_bf16(a, bb, acc[b], 0, 0, 0); } }
    float ar[2], ai[2];
#pragma unroll
    for (int b = 0; b < 2; ++b) { ar[b] = A32[(g * NP + 32 * b + r32) * 2]; ai[b] = A32[(g * NP + 32 * b + r32) * 2 + 1]; }
    LAS float* xe = (LAS float*)L;
    float xr[2], xi[2];
#define SSM_SCAN(STORE) do { _Pragma("unroll") for (int q = 0; q < 8; ++q) { const int rb = 4 * (q >> 1); const bool own = (hi == (q & 1)); \
        _Pragma("unroll") for (int j = 0; j < 4; ++j) { \
            _Pragma("unroll") for (int b = 0; b < 2; ++b) { \
                if (STORE) { if (own) { bf16* row = ASSM + (size_t)(g * SNC + 32 * wave + 4 * q + j) * SK; row[32 * b + r32] = (bf16)f2bf(xr[b]); row[64 + 32 * b + r32] = (bf16)f2bf(xi[b]); } } \
                const float nr = ar[b] * xr[b] - ai[b] * xi[b] + acc[b][rb + j], ni = ar[b] * xi[b] + ai[b] * xr[b] + acc[b + 2][rb + j]; xr[b] = nr; xi[b] = ni; } } \
        _Pragma("unroll") for (int b = 0; b < 2; ++b) { const float orr = __shfl_xor(xr[b], 32), oi = __shfl_xor(xi[b], 32); if (!own) { xr[b] = orr; xi[b] = oi; } } } } while (0)
    xr[0] = xr[1] = xi[0] = xi[1] = 0.f;
    SSM_SCAN(false);
    if (hi == 0) {
#pragma unroll
        for (int b = 0; b < 2; ++b) { xe[((wave * 64) + 32 * b + r32) * 2] = xr[b]; xe[((wave * 64) + 32 * b + r32) * 2 + 1] = xi[b]; } }
    __syncthreads();
    float sr[2], si[2];
#pragma unroll
    for (int b = 0; b < 2; ++b) { float pr = ar[b], pi = ai[b];
#pragma unroll
        for (int k = 0; k < 5; ++k) { const float nr = pr * pr - pi * pi, ni = 2.f * pr * pi; pr = nr; pi = ni; }
        sr[b] = 0.f; si[b] = 0.f;
        for (int w = 0; w < wave; ++w) { const float er = xe[((w * 64) + 32 * b + r32) * 2], ei = xe[((w * 64) + 32 * b + r32) * 2 + 1]; const float nr = pr * sr[b] - pi * si[b] + er, ni = pr * si[b] + pi * sr[b] + ei; sr[b] = nr; si[b] = ni; } }
    xr[0] = sr[0]; xr[1] = sr[1]; xi[0] = si[0]; xi[1] = si[1];
    SSM_SCAN(true);
#undef SSM_SCAN
    asm volatile("s_waitcnt vmcnt(0)" ::: "memory");
    __syncthreads();
}
namespace gp {
struct OneUnit { Unit u; __device__ __forceinline__ bool next(int i, Unit& o) const { if (i) return false; o = u; return true; } };
struct EpiSsmY {
    static constexpr bool PERM = true; const bf16_t* assm; const float* dsk; bf16_t* yact;
    __device__ __forceinline__ bool operator()(Acc& acc, const Unit& u, int wr, int wc, int fr, int fq) const {
        const int g = u.pm;
#pragma unroll
        for (int bj = 0; bj < 2; ++bj) { const int col = bj * HALF + wc * 32 + 8 * fq, t = u.pn * 16 + (col >> 4), h0 = col & 15;
            const f32x4 d0 = *(const f32x4*)(dsk + g * 16 + h0), d1 = *(const f32x4*)(dsk + g * 16 + h0 + 4);
#pragma unroll
            for (int ai = 0; ai < 2; ++ai)
#pragma unroll
                for (int m = 0; m < 4; ++m) { const int c = ai * HALF + wr * 64 + m * 16 + fr;
                    const u32x4 uw = *(const u32x4*)(assm + (size_t)(g * SNC + c) * SK + 128 + t * 16 + h0);
                    f32x4 v0 = acc[ai][bj][m][0], v1 = acc[ai][bj][m][1];
                    v0[0] += d0[0] * bflo(uw.x); v0[1] += d0[1] * bfhi(uw.x); v0[2] += d0[2] * bflo(uw.y); v0[3] += d0[3] * bfhi(uw.y);
                    v1[0] += d1[0] * bflo(uw.z); v1[1] += d1[1] * bfhi(uw.z); v1[2] += d1[2] * bflo(uw.w); v1[3] += d1[3] * bfhi(uw.w);
#pragma unroll
                    for (int e = 0; e < 4; ++e) { v0[e] = gelu_fast(v0[e]); v1[e] = gelu_fast(v1[e]); }
                    u32x4 w; w.x = cvt_pk_bf16(v0[0], v0[1]); w.y = cvt_pk_bf16(v0[2], v0[3]); w.z = cvt_pk_bf16(v1[0], v1[1]); w.w = cvt_pk_bf16(v1[2], v1[3]);
                    *(u32x4*)(yact + (size_t)(c * SL + t) * SSMW + g * 16 + h0) = w; } }
        return false;
    }
};
}
constexpr int SG_PITCH = 272;
constexpr int SG_WT = 0, SG_VT = 128 * SG_PITCH, SG_MU = 2 * 128 * SG_PITCH, SG_RS = SG_MU + 512, SG_END = SG_RS + 512;
__device__ __forceinline__ void sgu_stage_w(LAS unsigned char* L, int h, int tid, const float* sgu_w) {
    const int t = tid >> 2, s0 = (tid & 3) * 32; const float* wr = sgu_w + ((size_t)h * SGC + t) * SGC + s0;
#pragma unroll
    for (int j = 0; j < 4; ++j) { const f32x4 a = *(const f32x4*)(wr + 8 * j), b = *(const f32x4*)(wr + 8 * j + 4); const int s = s0 + 8 * j; float v[8] = {a[0], a[1], a[2], a[3], b[0], b[1], b[2], b[3]};
#pragma unroll
        for (int e = 0; e < 8; ++e) v[e] = (s + e <= t) ? v[e] : 0.f;
        v4u o; o.x = pk2(v[0], v[1]); o.y = pk2(v[2], v[3]); o.z = pk2(v[4], v[5]); o.w = pk2(v[6], v[7]);
        *(LAS v4u*)(L + SG_WT + t * SG_PITCH + s * 2) = o; }
}
__device__ __forceinline__ void sgu_item(LAS unsigned char* L, int h, int c, int tid, int lane, int wave, const bf16* VT, const float* STAT_V, const float* ln_g, const float* ln_b, const float* sgu_b,
                                         const bf16* UACT, bf16* AOUT, float* SS_SGU) {
    LAS float* MU = (LAS float*)(L + SG_MU); LAS float* RS = (LAS float*)(L + SG_RS);
    if (tid < SGC) { const int tok = c * SGC + tid; const float s1 = STAT_V[2 * tok], s2 = STAT_V[2 * tok + 1]; const float mu = s1 * (1.0f / SGUW); const float var = s2 * (1.0f / SGUW) - mu * mu;
        MU[tid] = mu; RS[tid] = 1.0f / sqrtf(var + EPS); }
    __syncthreads();
    { const int d = tid >> 2, s0 = (tid & 3) * 32, ch = h * SGD + d; const float gg = ln_g[ch], bb = ln_b[ch]; const bf16* vr = VT + (size_t)ch * SEQ + c * SGC + s0;
#pragma unroll
      for (int j = 0; j < 4; ++j) { const v4u w = *(const v4u*)(vr + 8 * j); const int s = s0 + 8 * j; float v[8] = {bflo(w.x), bfhi(w.x), bflo(w.y), bfhi(w.y), bflo(w.z), bfhi(w.z), bflo(w.w), bfhi(w.w)};
#pragma unroll
          for (int e = 0; e < 8; ++e) v[e] = (v[e] - MU[s + e]) * RS[s + e] * gg + bb;
          v4u o; o.x = pk2(v[0], v[1]); o.y = pk2(v[2], v[3]); o.z = pk2(v[4], v[5]); o.w = pk2(v[6], v[7]);
          *(LAS v4u*)(L + SG_VT + d * SG_PITCH + s * 2) = o; } }
    __syncthreads();
    const int fr = lane & 15, fq = lane >> 4; const int nkb = (wave >> 1) + 1;
    f32x4 acc[8];
#pragma unroll
    for (int nb = 0; nb < 8; ++nb) acc[nb] = (f32x4){0.f, 0.f, 0.f, 0.f};
    for (int kb = 0; kb < nkb; ++kb) { const bf16x8v wf = *(const LAS bf16x8v*)(L + SG_WT + (16 * wave + fr) * SG_PITCH + (32 * kb + 8 * fq) * 2);
#pragma unroll
        for (int nb = 0; nb < 8; ++nb) { const bf16x8v vf = *(const LAS bf16x8v*)(L + SG_VT + (16 * nb + fr) * SG_PITCH + (32 * kb + 8 * fq) * 2);
            acc[nb] = __builtin_amdgcn_mfma_f32_16x16x32_bf16(vf, wf, acc[nb], 0, 0, 0); } }
    const int t = 16 * wave + fr, token = c * SGC + t; const float bias = sgu_b[h * SGC + t]; float ss = 0.f;
#pragma unroll
    for (int nb = 0; nb < 8; ++nb) { const int d0 = 16 * nb + 4 * fq; const uint2 uw = *(const uint2*)(UACT + (size_t)token * SGUW + h * SGD + d0);
        const float o0 = bflo(uw.x) * (acc[nb][0] + bias), o1 = bfhi(uw.x) * (acc[nb][1] + bias), o2 = bflo(uw.y) * (acc[nb][2] + bias), o3 = bfhi(uw.y) * (acc[nb][3] + bias);
        ss += (o0 * o0 + o1 * o1) + (o2 * o2 + o3 * o3);
        uint2 ow; ow.x = pk2(o0, o1); ow.y = pk2(o2, o3); *(uint2*)(AOUT + (size_t)token * DM + SSMW + h * SGD + d0) = ow; }
    ss += __shfl_xor(ss, 16); ss += __shfl_xor(ss, 32);
    if (fq == 0) (void)__hip_atomic_fetch_add(SS_SGU + token, ss, __ATOMIC_RELAXED, __HIP_MEMORY_SCOPE_AGENT);
    __syncthreads();
}
namespace gp {
struct P1Sched { StaticOrder so; const char* X; const char* W; int ld;
    __device__ __forceinline__ bool next(int i, Unit& u) const { pg8::Unit q; if (!so.next(i, q)) return false; u.pm = q.pm; u.pn = q.pn; u.nt = DM / BK;
        const char* xa = X + (size_t)q.pm * BM * ld; const char* wb = W + (size_t)q.pn * BM * ld;
        if (q.pn < 8) { u.a = xa; u.b = wb; u.kind = q.pn < 4 ? 0 : 1; } else { u.a = wb; u.b = xa; u.kind = 2; } return true; }
};
struct EpiP1 {
    static constexpr bool PERM = true; bf16_t* assm; bf16_t* uact; bf16_t* vt; float* statv;
    __device__ __forceinline__ bool operator()(Acc& acc, const Unit& u, int wr, int wc, int fr, int fq) const {
        if (u.kind == 2) {
            float s[2][8], q[2][8];
#pragma unroll
            for (int bj = 0; bj < 2; ++bj)
#pragma unroll
                for (int e = 0; e < 8; ++e) { s[bj][e] = 0.f; q[bj][e] = 0.f; }
            const int ch0 = (u.pn - 8) * BM + wr * 64 + fr, tok0 = u.pm * BM + wc * 32 + 8 * fq;
#pragma unroll
            for (int ai = 0; ai < 2; ++ai)
#pragma unroll
                for (int m = 0; m < 4; ++m) { bf16_t* rowp = vt + (size_t)(ch0 + ai * HALF + m * 16) * SEQ + tok0;
#pragma unroll
                    for (int bj = 0; bj < 2; ++bj) { float v[8];
#pragma unroll
                        for (int e = 0; e < 8; ++e) { v[e] = gelu_fast(acc[ai][bj][m][e >> 2][e & 3]); s[bj][e] += v[e]; q[bj][e] += v[e] * v[e]; }
                        u32x4 w; w.x = cvt_pk_bf16(v[0], v[1]); w.y = cvt_pk_bf16(v[2], v[3]); w.z = cvt_pk_bf16(v[4], v[5]); w.w = cvt_pk_bf16(v[6], v[7]);
                        *(u32x4*)(rowp + bj * HALF) = w; } }
#pragma unroll
            for (int bj = 0; bj < 2; ++bj)
#pragma unroll
                for (int e = 0; e < 8; ++e) {
#pragma unroll
                    for (int o = 1; o < 16; o <<= 1) { s[bj][e] += __shfl_xor(s[bj][e], o); q[bj][e] += __shfl_xor(q[bj][e], o); }
                    if (fr == 0) { float* st = statv + (size_t)(tok0 + bj * HALF + e) * 2;
                        (void)__hip_atomic_fetch_add(st, s[bj][e], __ATOMIC_RELAXED, __HIP_MEMORY_SCOPE_AGENT); (void)__hip_atomic_fetch_add(st + 1, q[bj][e], __ATOMIC_RELAXED, __HIP_MEMORY_SCOPE_AGENT); } }
            return false;
        }
        const int row0 = u.pm * BM + wr * 64 + fr, col0 = u.pn * BM + wc * 32 + 8 * fq;
#pragma unroll
        for (int ai = 0; ai < 2; ++ai)
#pragma unroll
            for (int m = 0; m < 4; ++m) { const int row = row0 + ai * HALF + m * 16;
#pragma unroll
                for (int bj = 0; bj < 2; ++bj) { f32x4 v0 = acc[ai][bj][m][0], v1 = acc[ai][bj][m][1]; const int col = col0 + bj * HALF;
                    if (u.kind == 1) {
#pragma unroll
                        for (int e = 0; e < 4; ++e) { v0[e] = gelu_fast(v0[e]); v1[e] = gelu_fast(v1[e]); } }
                    u32x4 w; w.x = cvt_pk_bf16(v0[0], v0[1]); w.y = cvt_pk_bf16(v0[2], v0[3]); w.z = cvt_pk_bf16(v1[0], v1[1]); w.w = cvt_pk_bf16(v1[2], v1[3]);
                    if (u.kind == 0) *(u32x4*)(assm + (size_t)((col >> 4) * SNC + (row >> 5)) * SK + 128 + (row & 31) * 16 + (col & 15)) = w;
                    else *(u32x4*)(uact + (size_t)row * SGUW + (col - SSMW)) = w; } }
        return false;
    }
};
struct EpiGlu {
    static constexpr bool PERM = true; const bf16_t* yact; const float* gb; bf16_t* aout; float* ss;
    __device__ __forceinline__ bool operator()(Acc& acc, const Unit& u, int wr, int wc, int fr, int fq) const {
        const int row0 = u.pm * BM + wr * 64 + fr, col0 = u.pn * BM + wc * 32 + 8 * fq;
        f32x4 b0[2], b1[2];
#pragma unroll
        for (int bj = 0; bj < 2; ++bj) { b0[bj] = *(const f32x4*)(gb + col0 + bj * HALF); b1[bj] = *(const f32x4*)(gb + col0 + bj * HALF + 4); }
#pragma unroll
        for (int ai = 0; ai < 2; ++ai)
#pragma unroll
            for (int m = 0; m < 4; ++m) { const int row = row0 + ai * HALF + m * 16; float rs = 0.f;
#pragma unroll
                for (int bj = 0; bj < 2; ++bj) { const int col = col0 + bj * HALF; const u32x4 yw = *(const u32x4*)(yact + (size_t)row * SSMW + col);
                    const f32x4 z0 = acc[ai][bj][m][0] + b0[bj], z1 = acc[ai][bj][m][1] + b1[bj]; float o[8];
                    const float y[8] = {bflo(yw.x), bfhi(yw.x), bflo(yw.y), bfhi(yw.y), bflo(yw.z), bfhi(yw.z), bflo(yw.w), bfhi(yw.w)};
#pragma unroll
                    for (int e = 0; e < 8; ++e) { const float z = e < 4 ? z0[e & 3] : z1[e & 3]; o[e] = y[e] / (1.0f + __expf(-z)); rs += o[e] * o[e]; }
                    u32x4 w; w.x = cvt_pk_bf16(o[0], o[1]); w.y = cvt_pk_bf16(o[2], o[3]); w.z = cvt_pk_bf16(o[4], o[5]); w.w = cvt_pk_bf16(o[6], o[7]);
                    *(u32x4*)(aout + (size_t)row * DM + col) = w; }
                rs += __shfl_xor(rs, 16); rs += __shfl_xor(rs, 32);
                if (fq == 0) (void)__hip_atomic_fetch_add(ss + row, rs, __ATOMIC_RELAXED, __HIP_MEMORY_SCOPE_AGENT); }
        return false;
    }
};
struct OutSched { StaticOrder so; const char* A; const char* B; int ld;
    __device__ __forceinline__ bool next(int i, Unit& u) const { pg8::Unit q; if (!so.next(i >> 1, q)) return false; const int half = i & 1; u.pm = q.pm; u.pn = q.pn; u.nt = SSMW / BK; u.kind = half;
        u.a = A + (size_t)q.pm * BM * ld + half * (SSMW * 2); u.b = B + (size_t)q.pn * BM * ld + half * (SSMW * 2); return true; }
};
struct EpiOut {
    static constexpr bool PERM = true; const float* base; float* out; bf16_t* abf; float* ss; const float* ss_a; const float* ss_b;
    __device__ __forceinline__ bool operator()(Acc& acc, const Unit& u, int wr, int wc, int fr, int fq) const {
        const int row0 = u.pm * BM + wr * 64 + fr, col0 = u.pn * BM + wc * 32 + 8 * fq;
#pragma unroll
        for (int ai = 0; ai < 2; ++ai)
#pragma unroll
            for (int m = 0; m < 4; ++m) { const int row = row0 + ai * HALF + m * 16; const size_t off = (size_t)row * DM + col0;
                const float ra = 1.0f / sqrtf(ss_a[row] * (1.0f / SSMW) + EPS), rb = 1.0f / sqrtf(ss_b[row] * (1.0f / SGUW) + EPS);
                if (u.kind == 0) { const float f = ra / rb;
#pragma unroll
                    for (int bj = 0; bj < 2; ++bj) { acc[ai][bj][m][0] *= f; acc[ai][bj][m][1] *= f; } }
                else { float rs = 0.f;
#pragma unroll
                    for (int bj = 0; bj < 2; ++bj) { const f32x4 v0 = acc[ai][bj][m][0] * rb + *(const f32x4*)(base + off + bj * HALF), v1 = acc[ai][bj][m][1] * rb + *(const f32x4*)(base + off + bj * HALF + 4);
                        *(f32x4*)(out + off + bj * HALF) = v0; *(f32x4*)(out + off + bj * HALF + 4) = v1;
                        rs += (v0[0] * v0[0] + v0[1] * v0[1]) + (v0[2] * v0[2] + v0[3] * v0[3]) + (v1[0] * v1[0] + v1[1] * v1[1]) + (v1[2] * v1[2] + v1[3] * v1[3]);
                        u32x4 w; w.x = cvt_pk_bf16(v0[0], v0[1]); w.y = cvt_pk_bf16(v0[2], v0[3]); w.z = cvt_pk_bf16(v1[0], v1[1]); w.w = cvt_pk_bf16(v1[2], v1[3]); *(u32x4*)(abf + off + bj * HALF) = w; }
                    rs += __shfl_xor(rs, 16); rs += __shfl_xor(rs, 32);
                    if (fq == 0) (void)__hip_atomic_fetch_add(ss + row, rs, __ATOMIC_RELAXED, __HIP_MEMORY_SCOPE_AGENT); } }
        return u.kind == 0;
    }
};
}
#ifndef MK_N_LAUNCHES
#define MK_N_LAUNCHES 1
#endif
constexpr int PER_PHASE = 8;
constexpr int N_LAUNCHES = MK_N_LAUNCHES;
struct Args { const float* in[24]; float* out; unsigned char* ws; int ph_lo, ph_hi; };
static_assert(sizeof(Args) == 24 * 8 + 8 + 8 + 8, "Args has no padding");

__global__ void __launch_bounds__(NWAVES * 64, 2) fwd(Args args) {
    extern __shared__ __attribute__((aligned(16))) unsigned char lds_raw[];
    LAS unsigned char* L = (LAS unsigned char*)lds_raw;
    const int tid = threadIdx.x, lane = tid & 63, wave = __builtin_amdgcn_readfirstlane(tid >> 6);
    const int gw = blockIdx.x * NWAVES + wave, ngw = gridDim.x * NWAVES;
    volatile LAS unsigned* MISC = (volatile LAS unsigned*)(L + MISC_OFF);
    for (int u = tid; u < 32; u += NWAVES * 64) MISC[u] = 0u;
    __syncthreads();
    unsigned char* ws = args.ws;
    XcdBarrier bar; bar.bar = (unsigned*)(ws + WS_CTL) + CW_BAR; bar.x = 0; bar.st = nullptr;
    if (N_LAUNCHES != PER_PHASE) bar = xcd_barrier_post((unsigned*)(ws + WS_CTL) + CW_BAR, MISC + 8);
    const float* x = args.in[0]; const float* g_mix = args.in[1]; const float* w_in = args.in[2];
    const float* a_re = args.in[3]; const float* a_im = args.in[4]; const float* b_re = args.in[5]; const float* b_im = args.in[6];
    const float* c_re = args.in[7]; const float* c_im = args.in[8]; const float* ssm_d = args.in[9]; const float* log_dt = args.in[10];
    const float* glu_w = args.in[11]; const float* glu_b = args.in[12]; const float* ln_g = args.in[13]; const float* ln_b = args.in[14];
    const float* sgu_w = args.in[15]; const float* sgu_b = args.in[16]; const float* g_ssm = args.in[17]; const float* g_sgu = args.in[18];
    const float* w_out = args.in[19]; const float* g_mlp = args.in[20]; const float* w_up = args.in[21]; const float* w_down = args.in[22];
    const float* g_fin = args.in[23];
    float* out = args.out;
    bf16* WUPT = (bf16*)(ws + WS_WUPT); bf16* WDOWNT = (bf16*)(ws + WS_WDOWNT); bf16* AMLP = (bf16*)(ws + WS_AMLP); bf16* H = (bf16*)(ws + WS_H);
    bf16* WINT = (bf16*)(ws + WS_WINT); bf16* GLUT = (bf16*)(ws + WS_GLUT); bf16* WOUTT = (bf16*)(ws + WS_WOUTT); bf16* H0 = (bf16*)(ws + WS_H0);
    bf16* VT = (bf16*)(ws + WS_VT); bf16* UACT = (bf16*)(ws + WS_UACT); bf16* YACT = (bf16*)(ws + WS_YACT); bf16* AOUT = (bf16*)(ws + WS_AOUT);
    bf16* TTAB = (bf16*)(ws + WS_TTAB); bf16* PTAB = (bf16*)(ws + WS_PTAB); bf16* ASSM = (bf16*)(ws + WS_ASSM); float* A32 = (float*)(ws + WS_A32);
    float* SS_X1 = (float*)(ws + WS_STAT); float* SS_X2 = SS_X1 + SEQ; float* SS_SSM = SS_X2 + SEQ; float* SS_SGU = SS_SSM + SEQ; float* STAT_V = SS_SGU + SEQ;

    const int lo = args.ph_lo, hi = args.ph_hi;
#define IN(k) (lo <= (k) && (k) < hi)
#define SEAM(k) do { if (IN(k) && IN((k) + 1)) xcd_barrier(bar); } while (0)
#define GEMM_PHASE(EPI, A_, BT_, M_, N_, K_, ...) do { gp::StdSched S; S.init(A_, BT_, M_, N_, K_, (int)gridDim.x, (int)blockIdx.x); \
        EPI Ep{__VA_ARGS__}; gp::gemm_phase<EPI, gp::StdSched, true, true>(L + RING_OFF, (K_) * 2, S, Ep); } while (0)

    if (IN(0)) {
        if (blockIdx.x < NG) ssm_build_tables(L + RING_OFF, (int)blockIdx.x, tid, a_re, a_im, b_re, b_im, c_re, c_im, log_dt, TTAB, PTAB, A32);
        LAS float* scr = (LAS float*)(L + RING_OFF + wave * 16384);
        constexpr int I_IN = (DM / 64) * (INW / 32), I_GLU = (SSMW / 64) * (SSMW / 32), I_OUT = (DM / 64) * (DM / 32);
        constexpr int NITEMS = I_IN + I_GLU + I_OUT;
        for (int it = gw; it < NITEMS; it += ngw) {
            int r = it;
            if (r < I_IN) { transpose_item(w_in, DM, INW, g_mix, g_mix, DM, WINT, scr, r, lane); continue; } r -= I_IN;
            if (r < I_GLU) { transpose_item(glu_w, SSMW, SSMW, nullptr, nullptr, 0, GLUT, scr, r, lane); continue; } r -= I_GLU;
            transpose_item(w_out, DM, DM, g_ssm, g_sgu, SSMW, WOUTT, scr, r, lane);
        }
        for (int r = gw; r < SEQ; r += ngw) rms_row_bf16(x + (size_t)r * DM, H0 + (size_t)r * DM, lane);
        for (int i = blockIdx.x * (NWAVES * 64) + tid; i < 6 * SEQ; i += gridDim.x * (NWAVES * 64)) SS_X1[i] = 0.f;
    }
    SEAM(0);
    if (IN(1)) {
        { gp::P1Sched S; S.so.init(SEQ, INW, (int)gridDim.x, (int)blockIdx.x); S.X = (const char*)H0; S.W = (const char*)WINT; S.ld = DM * 2;
          gp::EpiP1 Ep{ASSM, UACT, VT, STAT_V};
          gp::gemm_phase<gp::EpiP1, gp::P1Sched, true, true>(L + RING_OFF, DM * 2, S, Ep); }
        if ((int)blockIdx.x >= 128) {
            __syncthreads();
            LAS float* scr = (LAS float*)(L + RING_OFF + wave * 16384);
            constexpr int I_UP = (DM / 64) * (DFF / 32), I_DN = (DFF / 64) * (DM / 32);
            for (int it = ((int)blockIdx.x - 128) * NWAVES + wave; it < I_UP + I_DN; it += ((int)gridDim.x - 128) * NWAVES) {
                if (it < I_UP) transpose_item(w_up, DM, DFF, g_mlp, g_mlp, DM, WUPT, scr, it, lane);
                else transpose_item(w_down, DFF, DM, nullptr, nullptr, 0, WDOWNT, scr, it - I_UP, lane);
            }
        }
    }
    SEAM(1);
    if (IN(2)) {
        if (blockIdx.x < 2 * NG) { const int g = (int)blockIdx.x >> 1, hf = (int)blockIdx.x & 1;
            ssm_states(L + RING_OFF, g, lane, wave, ASSM, PTAB, A32);
            gp::OneUnit S; S.u.a = (const char*)(ASSM + (size_t)g * SNC * SK); S.u.b = (const char*)(TTAB + (size_t)(g * 512 + hf * 256) * SK); S.u.pm = g; S.u.pn = hf; S.u.nt = hf ? 10 : 6; S.u.kind = 0;
            gp::EpiSsmY Ep{ASSM, ssm_d, YACT};
            gp::gemm_phase<gp::EpiSsmY, gp::OneUnit, true, true>(L + RING_OFF, SK * 2, S, Ep);
        } else {
            const int nw = (int)gridDim.x - 2 * NG;
            for (int it0 = ((int)blockIdx.x - 2 * NG) * 4; it0 < SGH * (SEQ / SGC); it0 += nw * 4) { const int h = it0 >> 6;
                sgu_stage_w(L + RING_OFF, h, tid, sgu_w);
                for (int i = 0; i < 4; ++i) sgu_item(L + RING_OFF, h, (it0 & 63) + i, tid, lane, wave, VT, STAT_V, ln_g, ln_b, sgu_b, UACT, AOUT, SS_SGU);
            }
        }
    }
    SEAM(2);
    if (IN(3)) GEMM_PHASE(gp::EpiGlu, YACT, GLUT, SEQ, SSMW, SSMW, YACT, glu_b, AOUT, SS_SSM);
    SEAM(3);
    if (IN(4)) { gp::OutSched S; S.so.init(SEQ, DM, (int)gridDim.x, (int)blockIdx.x); S.A = (const char*)AOUT; S.B = (const char*)WOUTT; S.ld = DM * 2;
        gp::EpiOut Ep{x, out, AMLP, SS_X1, SS_SSM, SS_SGU};
        gp::gemm_phase<gp::EpiOut, gp::OutSched, true, true>(L + RING_OFF, DM * 2, S, Ep); }
    SEAM(4);
    if (IN(5)) GEMM_PHASE(gp::EpiH, AMLP, WUPT, SEQ, DFF, DM, H, SS_X1, DFF, 1.0f / DM, EPS);
    SEAM(5);
    if (IN(6)) GEMM_PHASE(gp::EpiRes, H, WDOWNT, SEQ, DM, DFF, out, out, nullptr, SS_X2, DM);
    SEAM(6);
    if (IN(7)) { for (int r = gw; r < SEQ; r += ngw) { const float rs = 1.0f / sqrtf(SS_X2[r] * (1.0f / DM) + EPS);
        f32x4* xr = (f32x4*)(out + (size_t)r * DM) + lane; const f32x4* gr = (const f32x4*)g_fin + lane;
#pragma unroll
        for (int j = 0; j < 8; ++j) xr[64 * j] = xr[64 * j] * rs * gr[64 * j]; } }
#undef IN
#undef SEAM
}

extern "C" void kernel_launch(void* const* d_in, const int* in_sizes, int n_in, void* d_out, int out_size, void* d_ws, size_t ws_size, hipStream_t stream) {
    static int grid = 0;
    if (grid == 0) {
        if (n_in != 24 || ws_size < WS_END) { fprintf(stderr, "kernel_launch: unexpected n_in %d / ws %zu\n", n_in, ws_size); grid = -1; return; }
        int dev = 0, cus = 0, per_cu = 0;
        if (hipGetDevice(&dev) != hipSuccess || hipDeviceGetAttribute(&cus, hipDeviceAttributeMultiprocessorCount, dev) != hipSuccess) { grid = -1; return; }
        if (hipFuncSetAttribute((const void*)fwd, hipFuncAttributeMaxDynamicSharedMemorySize, LDS_BYTES) != hipSuccess) { fprintf(stderr, "kernel_launch: hipFuncSetAttribute failed\n"); grid = -1; return; }
        if (hipOccupancyMaxActiveBlocksPerMultiprocessor(&per_cu, (const void*)fwd, NWAVES * 64, LDS_BYTES) != hipSuccess || per_cu < 1) { fprintf(stderr, "kernel_launch: occupancy query says %d blocks per CU\n", per_cu); }
        (void)hipGetLastError();
        grid = cus;
    }
    if (grid < 0) return;
    (void)hipMemsetAsync((char*)d_ws + WS_CTL, 0, CTL_ZERO_BYTES, stream);
    Args a{};
    for (int i = 0; i < 24; ++i) a.in[i] = (const float*)d_in[i];
    a.out = (float*)d_out; a.ws = (unsigned char*)d_ws;
    if (N_LAUNCHES == 1) { a.ph_lo = 0; a.ph_hi = PER_PHASE; hipLaunchKernelGGL(fwd, dim3(grid), dim3(NWAVES * 64), LDS_BYTES, stream, a); }
    else { for (int p = 0; p < PER_PHASE; ++p) { a.ph_lo = p; a.ph_hi = p + 1; hipLaunchKernelGGL(fwd, dim3(grid), dim3(NWAVES * 64), LDS_BYTES, stream, a); } }
}
```

```cpp
#include <hip/hip_runtime.h>
#include <cstdio>
#include <cstdint>
#ifndef PROBE
#define PROBE 0
#endif
namespace pg8 {
#define PG8_LAS __attribute__((address_space(3)))
typedef unsigned short bf16_t;
typedef short bf16x8 __attribute__((ext_vector_type(8)));
typedef float f32x4 __attribute__((ext_vector_type(4)));
typedef unsigned u32x4 __attribute__((ext_vector_type(4)));
constexpr int BM = 256, BK = 64, HALF = 128, HTB = HALF * BK * 2  , STAGE_BYTES = 8 * HTB, NXCD = 8, WGM = 8;

__host__ __device__ __forceinline__ int lds_byte(int r, int c) { const int st = (r >> 4) * 2 + (c >> 5), rr = r & 15, cc = c & 31, ob = rr * 64 + cc * 2; return st * 1024 + (ob ^ (((ob >> 9) & 1) << 5)); }
__host__ __device__ __forceinline__ void stage_rc(int b, int& R, int& C) { const int st = b / 1024, sb = b % 1024, swz = sb ^ (((sb >> 9) & 1) << 5); R = (st >> 1) * 16 + swz / 64; C = (st & 1) * 32 + (swz % 64) / 2; }
__host__ __device__ __forceinline__ int perm32(int rho) { const int n = rho >> 4, i = rho & 15; return 8 * (i >> 2) + 4 * n + (i & 3); }

struct Unit { int pm, pn; };
struct Gemm { const bf16_t* A; const bf16_t* Bt; int M, N, K; };

struct StaticOrder {
    int nM, nN, nwg, G, c;
    __host__ __device__ void init(int M, int N, int G_, int c_) { nM = M / BM; nN = N / BM; nwg = nM * nN; G = G_; c = c_; }
    __host__ __device__ bool next(int i, Unit& u) const {
        const long L = (long)i * G + c; if (L >= nwg) return false;
        int wgid = (int)L; { const int q = nwg / NXCD, r = nwg % NXCD, xcd = wgid % NXCD, off = wgid / NXCD; wgid = (xcd < r ? xcd * (q + 1) : r * (q + 1) + (xcd - r) * q) + off; }
        const int nig = WGM * nN, gid = wgid / nig, fm = gid * WGM, gsz = (nM - fm) < WGM ? (nM - fm) : WGM;
        u.pm = fm + ((wgid % nig) % gsz); u.pn = (wgid % nig) / gsz; return true;
    }
    __device__ __forceinline__ void a_ready(const Unit&) const {}
    __device__ __forceinline__ void done(const Unit&) const {}
};

__device__ __forceinline__ unsigned cvt_pk_bf16(float lo, float hi) { unsigned r; asm volatile("v_cvt_pk_bf16_f32 %0, %1, %2" : "=v"(r) : "v"(lo), "v"(hi)); return r; }
typedef float f32x2 __attribute__((ext_vector_type(2)));
}
namespace gp {
using namespace pg8;
struct Unit { const char* a; const char* b; int pm, pn, nt, kind; };
template <class Epi, class Sched, bool ALIGN_EPI = false, bool SP2 = false>
__device__ __forceinline__ void gemm_phase(PG8_LAS unsigned char* lds, const int ld  , const Sched& S, const Epi& E) {
    const int tid = threadIdx.x, wid = __builtin_amdgcn_readfirstlane(tid >> 6), lane = tid & 63, wr = wid >> 2, wc = wid & 3, fr = lane & 15, fq = lane >> 4;
    unsigned voffA[2], voffB[2];
#pragma unroll
    for (int i = 0; i < 2; ++i) { int R, C; stage_rc(tid * 16 + i * 8192, R, C); const int Rb = Epi::PERM ? ((R & ~31) + perm32(R & 31)) : R;
        voffA[i] = (unsigned)(R * ld + C * 2); voffB[i] = (unsigned)(Rb * ld + C * 2); }
    const size_t kstep = (size_t)(BK * 2);
    const size_t hstep = (size_t)HALF * ld;
    const unsigned ldsw = (unsigned)wid * 1024u;
    const int aoff = lds_byte(wr * 64 + fr, fq * 8), boff = lds_byte(wc * 32 + fr, fq * 8);
#define PG8_SA(b, h) (((b) * 2 + (h)) * HTB)
#define PG8_SB(b, h) ((4 + (b) * 2 + (h)) * HTB)
#define PG8_STAGE(bufoff, gbase, voff) do { _Pragma("unroll") for (int _i = 0; _i < 2; ++_i) \
        __builtin_amdgcn_global_load_lds((const unsigned*)((const char*)(gbase) + (voff)[_i]), (PG8_LAS unsigned*)(lds + (bufoff) + ldsw + _i * 8192), 16, 0, 0); } while (0)
#define PG8_LDA(dst, b, h) do { _Pragma("unroll") for (int m = 0; m < 4; ++m) _Pragma("unroll") for (int k = 0; k < 2; ++k) dst[m][k] = *(const PG8_LAS bf16x8*)(lds + PG8_SA(b, h) + aoff + m * 2048 + k * 1024); } while (0)
#define PG8_LDB(dst, b, h) do { _Pragma("unroll") for (int n = 0; n < 2; ++n) _Pragma("unroll") for (int k = 0; k < 2; ++k) dst[n][k] = *(const PG8_LAS bf16x8*)(lds + PG8_SB(b, h) + boff + n * 2048 + k * 1024); } while (0)
#define PG8_MMA(ai, bj, At, Bt) do { __builtin_amdgcn_s_setprio(1); _Pragma("unroll") for (int m = 0; m < 4; ++m) _Pragma("unroll") for (int n = 0; n < 2; ++n) _Pragma("unroll") for (int k = 0; k < 2; ++k) \
        acc[ai][bj][m][n] = __builtin_amdgcn_mfma_f32_16x16x32_bf16(Bt[n][k], At[m][k], acc[ai][bj][m][n], 0, 0, 0); __builtin_amdgcn_s_setprio(0); } while (0)
#define PG8_WAIT_V(n) asm volatile("s_waitcnt vmcnt(" #n ")" ::: "memory")
#define PG8_WAIT_L(n) asm volatile("s_waitcnt lgkmcnt(" #n ")" ::: "memory")
#define PG8_BAR __builtin_amdgcn_s_barrier()
#define PG8_SCHED __builtin_amdgcn_sched_barrier(0)
    Unit cur, nxt; int ui = 0;
    if (!S.next(0, cur)) return;
    f32x4 acc[2][2][4][2];
#pragma unroll
    for (int a = 0; a < 2; ++a)
#pragma unroll
        for (int b = 0; b < 2; ++b)
#pragma unroll
            for (int m = 0; m < 4; ++m)
#pragma unroll
                for (int n = 0; n < 2; ++n) acc[a][b][m][n] = (f32x4){0.f, 0.f, 0.f, 0.f};
    bf16x8 At[4][2], B0[2][2], B1[2][2];
    const char* cA = cur.a; const char* cB = cur.b;
    if constexpr (SP2) {
        PG8_STAGE(PG8_SB(0, 0), cB, voffB); PG8_STAGE(PG8_SB(0, 1), cB + hstep, voffB); PG8_STAGE(PG8_SA(0, 0), cA, voffA); PG8_STAGE(PG8_SA(0, 1), cA + hstep, voffA);
        if (wr == 1) PG8_BAR;
        PG8_WAIT_V(2); PG8_BAR;
        PG8_STAGE(PG8_SB(1, 0), cB + kstep, voffB); PG8_STAGE(PG8_SA(1, 0), cA + kstep, voffA); PG8_STAGE(PG8_SB(1, 1), cB + hstep + kstep, voffB);
        PG8_WAIT_V(6); PG8_BAR;
    } else {
        PG8_STAGE(PG8_SB(0, 0), cB, voffB); PG8_STAGE(PG8_SA(0, 0), cA, voffA); PG8_STAGE(PG8_SB(0, 1), cB + hstep, voffB); PG8_STAGE(PG8_SA(0, 1), cA + hstep, voffA);
        if (wr == 1) PG8_BAR;
        PG8_WAIT_V(4); PG8_BAR;
        PG8_STAGE(PG8_SB(1, 0), cB + kstep, voffB); PG8_STAGE(PG8_SA(1, 0), cA + kstep, voffA); PG8_STAGE(PG8_SB(1, 1), cB + hstep + kstep, voffB);
        PG8_WAIT_V(6); PG8_BAR;
    }
    for (;;) {
        const bool has_next = S.next(ui + 1, nxt);
        const char* nA = has_next ? nxt.a : cA; const char* nB = has_next ? nxt.b : cB;
        const int nt = cur.nt;
        for (int t = 0; t < nt; t += 2) {
            const bool last = (t == nt - 2);
            const char* a1 = cA + (size_t)(t + 1) * kstep;
            const char* a2 = last ? nA : cA + (size_t)(t + 2) * kstep; const char* b2 = last ? nB : cB + (size_t)(t + 2) * kstep;
            const char* a3 = a2 + kstep; const char* b3 = b2 + kstep;
            if constexpr (SP2) {
            PG8_LDB(B0, 0, 0); PG8_LDB(B1, 0, 1); PG8_SCHED; PG8_LDA(At, 0, 0); PG8_STAGE(PG8_SA(1, 1), a1 + hstep, voffA);
            PG8_WAIT_V(8); PG8_WAIT_L(0); PG8_BAR; PG8_MMA(0, 0, At, B0); PG8_MMA(0, 1, At, B1); PG8_BAR; PG8_SCHED;
            PG8_LDA(At, 0, 1); PG8_STAGE(PG8_SB(0, 0), b2, voffB); PG8_STAGE(PG8_SB(0, 1), b2 + hstep, voffB); PG8_STAGE(PG8_SA(0, 0), a2, voffA);
            PG8_WAIT_V(8); PG8_WAIT_L(0); PG8_BAR; PG8_MMA(1, 0, At, B0); PG8_MMA(1, 1, At, B1); PG8_BAR; PG8_SCHED;
            PG8_LDB(B0, 1, 0); PG8_LDB(B1, 1, 1); PG8_SCHED; PG8_LDA(At, 1, 0); PG8_STAGE(PG8_SA(0, 1), a2 + hstep, voffA);
            PG8_WAIT_V(8); PG8_WAIT_L(0); PG8_BAR; PG8_MMA(0, 0, At, B0); PG8_MMA(0, 1, At, B1); PG8_BAR; PG8_SCHED;
            PG8_LDA(At, 1, 1); PG8_STAGE(PG8_SB(1, 0), b3, voffB); PG8_STAGE(PG8_SB(1, 1), b3 + hstep, voffB); PG8_STAGE(PG8_SA(1, 0), a3, voffA);
            PG8_WAIT_V(8); PG8_WAIT_L(0); PG8_BAR; PG8_MMA(1, 0, At, B0); PG8_MMA(1, 1, At, B1); PG8_BAR; PG8_SCHED;
            } else {
            PG8_LDB(B0, 0, 0); PG8_SCHED; PG8_LDA(At, 0, 0); PG8_STAGE(PG8_SA(1, 1), a1 + hstep, voffA);
            PG8_WAIT_L(8); PG8_BAR; PG8_WAIT_L(0); PG8_MMA(0, 0, At, B0); PG8_BAR; PG8_SCHED;
            PG8_LDB(B1, 0, 1); PG8_STAGE(PG8_SB(0, 0), b2, voffB);
            PG8_BAR; PG8_WAIT_L(0); PG8_MMA(0, 1, At, B1); PG8_BAR;
            PG8_LDA(At, 0, 1); PG8_STAGE(PG8_SA(0, 0), a2, voffA);
            PG8_BAR; PG8_WAIT_L(0); PG8_MMA(1, 0, At, B0); PG8_BAR; PG8_SCHED;
            PG8_STAGE(PG8_SB(0, 1), b2 + hstep, voffB);
            PG8_WAIT_V(6); PG8_BAR; PG8_MMA(1, 1, At, B1); PG8_BAR;
            PG8_LDB(B0, 1, 0); PG8_SCHED; PG8_LDA(At, 1, 0); PG8_STAGE(PG8_SA(0, 1), a2 + hstep, voffA);
            PG8_WAIT_L(8); PG8_BAR; PG8_WAIT_L(0); PG8_MMA(0, 0, At, B0); PG8_BAR; PG8_SCHED;
            PG8_LDB(B1, 1, 1); PG8_STAGE(PG8_SB(1, 0), b3, voffB);
            PG8_BAR; PG8_WAIT_L(0); PG8_MMA(0, 1, At, B1); PG8_BAR;
            PG8_LDA(At, 1, 1); PG8_STAGE(PG8_SA(1, 0), a3, voffA);
            PG8_BAR; PG8_WAIT_L(0); PG8_MMA(1, 0, At, B0); PG8_BAR; PG8_SCHED;
            PG8_STAGE(PG8_SB(1, 1), b3 + hstep, voffB);
            PG8_WAIT_V(6); PG8_BAR; PG8_MMA(1, 1, At, B1); PG8_BAR;
            }
        }
        if constexpr (ALIGN_EPI) { if (wr == 0) PG8_BAR; }
        const bool keep = E(acc, cur, wr, wc, fr, fq);
        if (!has_next) break;
        if (!keep)
#pragma unroll
        for (int a = 0; a < 2; ++a)
#pragma unroll
            for (int b = 0; b < 2; ++b)
#pragma unroll
                for (int m = 0; m < 4; ++m)
#pragma unroll
                    for (int n = 0; n < 2; ++n) acc[a][b][m][n] = (f32x4){0.f, 0.f, 0.f, 0.f};
        cur = nxt; cA = nA; cB = nB; ++ui;
        if constexpr (ALIGN_EPI) { if (wr == 1) PG8_BAR; }
    }
    PG8_WAIT_V(0);
    if constexpr (!ALIGN_EPI) { if (wr == 0) PG8_BAR; }
    PG8_BAR;
#undef PG8_SA
#undef PG8_SB
#undef PG8_STAGE
#undef PG8_LDA
#undef PG8_LDB
#undef PG8_MMA
#undef PG8_WAIT_V
#undef PG8_WAIT_L
#undef PG8_BAR
#undef PG8_SCHED
}
struct StdSched { StaticOrder so; const char* A; const char* B; int ld, nt;
    __device__ __forceinline__ void init(const void* A_, const void* B_, int M, int N, int K, int G, int c) { so.init(M, N, G, c); A = (const char*)A_; B = (const char*)B_; ld = K * 2; nt = K / BK; }
    __device__ __forceinline__ bool next(int i, Unit& u) const { pg8::Unit q; if (!so.next(i, q)) return false; u.pm = q.pm; u.pn = q.pn; u.a = A + (size_t)q.pm * BM * ld; u.b = B + (size_t)q.pn * BM * ld; u.nt = nt; u.kind = 0; return true; }
};
typedef f32x4 Acc[2][2][4][2];
struct EpiZ {
    static constexpr bool PERM = true; bf16_t* O; int ldc;
    __device__ __forceinline__ bool operator()(Acc& acc, const Unit& u, int wr, int wc, int fr, int fq) const {
        const int row0 = u.pm * BM + wr * 64 + fr, col0 = u.pn * BM + wc * 32 + 8 * fq;
#pragma unroll
        for (int ai = 0; ai < 2; ++ai)
#pragma unroll
            for (int m = 0; m < 4; ++m) { bf16_t* rowp = O + (size_t)(row0 + ai * HALF + m * 16) * ldc + col0;
#pragma unroll
                for (int bj = 0; bj < 2; ++bj) { const f32x4 v0 = acc[ai][bj][m][0], v1 = acc[ai][bj][m][1];
                    u32x4 w; w.x = cvt_pk_bf16(v0[0], v0[1]); w.y = cvt_pk_bf16(v0[2], v0[3]); w.z = cvt_pk_bf16(v1[0], v1[1]); w.w = cvt_pk_bf16(v1[2], v1[3]);
                    *(u32x4*)(rowp + bj * HALF) = w; } }
        return false;
    }
};
struct EpiF32 {
    static constexpr bool PERM = true; float* out; int ldc;
    __device__ __forceinline__ bool operator()(Acc& acc, const Unit& u, int wr, int wc, int fr, int fq) const {
        const int row0 = u.pm * BM + wr * 64 + fr, col0 = u.pn * BM + wc * 32 + 8 * fq;
#pragma unroll
        for (int ai = 0; ai < 2; ++ai)
#pragma unroll
            for (int m = 0; m < 4; ++m) { float* rowp = out + (size_t)(row0 + ai * HALF + m * 16) * ldc + col0;
#pragma unroll
                for (int bj = 0; bj < 2; ++bj) { *(f32x4*)(rowp + bj * HALF) = acc[ai][bj][m][0]; *(f32x4*)(rowp + bj * HALF + 4) = acc[ai][bj][m][1]; } }
        return false;
    }
};
struct EpiRes {
    static constexpr bool PERM = true; const float* base; float* out; bf16_t* abf; float* ss; int ldc;
    __device__ __forceinline__ bool operator()(Acc& acc, const Unit& u, int wr, int wc, int fr, int fq) const {
        const int row0 = u.pm * BM + wr * 64 + fr, col0 = u.pn * BM + wc * 32 + 8 * fq;
#pragma unroll
        for (int ai = 0; ai < 2; ++ai)
#pragma unroll
            for (int m = 0; m < 4; ++m) { const int row = row0 + ai * HALF + m * 16; const size_t off = (size_t)row * ldc + col0; float rs = 0.f;
#pragma unroll
                for (int bj = 0; bj < 2; ++bj) { const f32x4 v0 = acc[ai][bj][m][0] + *(const f32x4*)(base + off + bj * HALF), v1 = acc[ai][bj][m][1] + *(const f32x4*)(base + off + bj * HALF + 4);
                    *(f32x4*)(out + off + bj * HALF) = v0; *(f32x4*)(out + off + bj * HALF + 4) = v1;
                    rs += (v0[0] * v0[0] + v0[1] * v0[1]) + (v0[2] * v0[2] + v0[3] * v0[3]) + (v1[0] * v1[0] + v1[1] * v1[1]) + (v1[2] * v1[2] + v1[3] * v1[3]);
                    if (abf) { u32x4 w; w.x = cvt_pk_bf16(v0[0], v0[1]); w.y = cvt_pk_bf16(v0[2], v0[3]); w.z = cvt_pk_bf16(v1[0], v1[1]); w.w = cvt_pk_bf16(v1[2], v1[3]); *(u32x4*)(abf + off + bj * HALF) = w; } }
                rs += __shfl_xor(rs, 16); rs += __shfl_xor(rs, 32);
                if (fq == 0) (void)__hip_atomic_fetch_add(ss + row, rs, __ATOMIC_RELAXED, __HIP_MEMORY_SCOPE_AGENT); }
        return false;
    }
};
struct EpiH {
    static constexpr bool PERM = true; bf16_t* O; const float* ss; int ldc; float inv_n, eps;
    __device__ __forceinline__ bool operator()(Acc& acc, const Unit& u, int wr, int wc, int fr, int fq) const {
        const int row0 = u.pm * BM + wr * 64 + fr, col0 = u.pn * BM + wc * 32 + 8 * fq;
#pragma unroll
        for (int ai = 0; ai < 2; ++ai)
#pragma unroll
            for (int m = 0; m < 4; ++m) { const int row = row0 + ai * HALF + m * 16; bf16_t* rowp = O + (size_t)row * ldc + col0;
                const float r2 = 1.0f / (ss[row] * inv_n + eps);
#pragma unroll
                for (int bj = 0; bj < 2; ++bj) { f32x4 v0 = acc[ai][bj][m][0], v1 = acc[ai][bj][m][1];
#pragma unroll
                    for (int e = 0; e < 4; ++e) { const float a = fmaxf(v0[e], 0.f), b = fmaxf(v1[e], 0.f); v0[e] = a * a * r2; v1[e] = b * b * r2; }
                    u32x4 w; w.x = cvt_pk_bf16(v0[0], v0[1]); w.y = cvt_pk_bf16(v0[2], v0[3]); w.z = cvt_pk_bf16(v1[0], v1[1]); w.w = cvt_pk_bf16(v1[2], v1[3]);
                    *(u32x4*)(rowp + bj * HALF) = w; } }
        return false;
    }
};
}
constexpr int SEQ = 8192, DM = 2048, SSMW = 1024, SGUW = 1024, INW = 3072, DFF = 8192;
constexpr int NG = 64, NP = 64, NHG = 16, SGH = 8, SGD = 128, SGC = 128;
constexpr float EPS = 1e-6f;
typedef unsigned short bf16;
typedef unsigned v4u __attribute__((ext_vector_type(4)));
typedef float f32x4 __attribute__((ext_vector_type(4)));
#define LAS __attribute__((address_space(3)))

__device__ __forceinline__ unsigned f2bf(float f) { unsigned u = __builtin_bit_cast(unsigned, f); return (u + 0x7fffu + ((u >> 16) & 1u)) >> 16; }
__device__ __forceinline__ unsigned pk2(float lo, float hi) { return f2bf(lo) | (f2bf(hi) << 16); }
__device__ __forceinline__ float bf2f(unsigned short b) { return __builtin_bit_cast(float, (unsigned)b << 16); }
__device__ __forceinline__ float bflo(unsigned w) { return __builtin_bit_cast(float, w << 16); }
__device__ __forceinline__ float bfhi(unsigned w) { return __builtin_bit_cast(float, w & 0xffff0000u); }
__device__ __forceinline__ float wave_sum(float v) {
#pragma unroll
    for (int o = 1; o < 64; o <<= 1) v += __shfl_xor(v, o);
    return v;
}
__device__ __forceinline__ float gelu_tanh(float x) { return 0.5f * x * (1.0f + tanhf(0.7978845608028654f * (x + 0.044715f * x * x * x))); }

__device__ __forceinline__ float gelu_fast(float x) { const float u = x * (1.5957691216057308f + 0.0713548162726009f * x * x); return x / (1.0f + __expf(-u)); }
#define XB_TMO      128
#define XB_XCNT(j)  (256  + 64 * (j))
#define XB_XSUB(j)  (1280 + 64 * (j))
#define XB_XGEN(j)  (2304 + 64 * (j))
#define XB_TOP      3328
#define XB_TOPGEN   3392
#define XCD_BAR_WORDS 3456
#define XB_SPIN_CAP (1u << 18)

__device__ __forceinline__ unsigned xb_ld(unsigned* p)              { return __hip_atomic_load(p, __ATOMIC_RELAXED, __HIP_MEMORY_SCOPE_AGENT); }
__device__ __forceinline__ unsigned xb_add(unsigned* p, unsigned v) { return __hip_atomic_fetch_add(p, v, __ATOMIC_RELAXED, __HIP_MEMORY_SCOPE_AGENT); }
__device__ __forceinline__ unsigned xb_xcc_id() { return (unsigned)__builtin_amdgcn_s_getreg((3 << 11) | 20) & 0xFu; }
#define XB_SPIN(cond, bar) do { unsigned _sp = 0; while (cond) { __builtin_amdgcn_s_sleep(1); \
    if ((++_sp & 255u) == 0u) { if (xb_ld(&(bar)[XB_TMO])) break; if (_sp > XB_SPIN_CAP) { atomicAdd(&(bar)[XB_TMO], 1u); break; } } } } while (0)

struct XcdBarrier {
    unsigned* bar; unsigned x;
    volatile LAS unsigned* st;
};

__device__ __forceinline__ XcdBarrier xcd_barrier_post(unsigned* bar, volatile LAS unsigned* st) {
    XcdBarrier b; b.bar = bar; b.x = xb_xcc_id(); b.st = st;
    if (threadIdx.x == 0) (void)xb_add(&bar[XB_XCNT(b.x)], 1u);
    return b;
}
__device__ __forceinline__ void xcd_barrier_complete(unsigned* bar, unsigned x, unsigned& nloc, unsigned& nx) {
    const unsigned G = gridDim.x * gridDim.y * gridDim.z;
    unsigned sum, cnt, mine, sp = 0u;
    for (;;) {
        sum = 0u; cnt = 0u; mine = 0u;
#pragma unroll
        for (unsigned j = 0; j < 16; ++j) { const unsigned c = xb_ld(&bar[XB_XCNT(j)]); sum += c; cnt += (c > 0u) ? 1u : 0u; mine = (j == x) ? c : mine; }
        if (sum == G) break;
        __builtin_amdgcn_s_sleep(1);
        if ((++sp & 255u) == 0u) { if (xb_ld(&bar[XB_TMO])) break; if (sp > XB_SPIN_CAP) { atomicAdd(&bar[XB_TMO], 1u); break; } }
    }
    nloc = mine > 0u ? mine : 1u; nx = cnt > 0u ? cnt : 1u;
}

__device__ __forceinline__ void xcd_barrier(const XcdBarrier& b) {
    asm volatile("s_waitcnt vmcnt(0)" ::: "memory");
    __syncthreads();
    if (threadIdx.x == 0) {
        unsigned* bar = b.bar;
        __builtin_amdgcn_s_waitcnt(0);
        unsigned nloc = b.st[0], nx = b.st[1];
        if (nloc == 0u) { xcd_barrier_complete(bar, b.x, nloc, nx); b.st[0] = nloc; b.st[1] = nx; }
        const unsigned old = xb_add(&bar[XB_XSUB(b.x)], 1u);
        const unsigned gen = old / nloc;
        if (old + 1u == (gen + 1u) * nloc) {
            __builtin_amdgcn_fence(__ATOMIC_RELEASE, "agent");
            asm volatile("s_waitcnt vmcnt(0)" ::: "memory");
            const unsigned og = xb_add(&bar[XB_TOP], 1u);
            const unsigned tg = og / nx;
            if (og + 1u == (tg + 1u) * nx) xb_add(&bar[XB_TOPGEN], 1u);
            else XB_SPIN(xb_ld(&bar[XB_TOPGEN]) == tg, bar);
            __builtin_amdgcn_fence(__ATOMIC_ACQUIRE, "agent");
            xb_add(&bar[XB_XGEN(b.x)], 1u);
            asm volatile("s_waitcnt vmcnt(0)" ::: "memory");
        } else {
            XB_SPIN(xb_ld(&bar[XB_XGEN(b.x)]) == gen, bar);
            __builtin_amdgcn_fence(__ATOMIC_ACQUIRE, "agent");
            asm volatile("s_waitcnt vmcnt(0)" ::: "memory");
        }
    }
    __syncthreads();
}
constexpr size_t MiB = 1u << 20;
constexpr size_t WS_CTL = 0, CTL_ZERO_BYTES = 64 * 1024;
constexpr size_t WS_WUPT = 1 * MiB, WS_WDOWNT = 33 * MiB, WS_AMLP = 65 * MiB, WS_H = 97 * MiB;
constexpr size_t WS_WINT = 65 * MiB, WS_VT = 77 * MiB;
constexpr size_t WS_GLUT = 97 * MiB, WS_WOUTT = 99 * MiB, WS_H0 = 107 * MiB, WS_ASSM = 139 * MiB, WS_UACT = 159 * MiB, WS_YACT = 175 * MiB, WS_TTAB = 191 * MiB, WS_PTAB = 231 * MiB, WS_A32 = 239 * MiB;
constexpr size_t WS_AOUT = WS_H0, WS_END = 256 * MiB;
constexpr size_t WS_STAT = 256 * 1024;
constexpr int CW_BAR = 4096;
constexpr int RING_OFF = 0, RING_BYTES = 131072;
constexpr int MISC_OFF = RING_BYTES + 320;
constexpr int LDS_BYTES = 147456;
constexpr int NWAVES = 8;
typedef __attribute__((address_space(1))) unsigned gu32;
#define RLX_AGENT __ATOMIC_RELAXED, __HIP_MEMORY_SCOPE_AGENT

struct Ctx { LAS unsigned char* lds; int tid, lane, wave, gw, ngw; };

struct ConvJob { const float* W; const float* s0; const float* s1; bf16* WT; int K, N, split; };
__device__ __forceinline__ void conv_load(const ConvJob& J, int item, int lane, f32x4 (&v)[16]) {
    const int nblk = J.N / 64, k0 = 64 * (item / nblk), n0 = 64 * (item % nblk);
    const float* src = J.W + (size_t)(k0 + (lane >> 4)) * J.N + n0 + 4 * (lane & 15);
#pragma unroll
    for (int i = 0; i < 16; ++i) v[i] = *(const f32x4*)(src + (size_t)(4 * i) * J.N);
    if (J.s0) {
#pragma unroll
        for (int i = 0; i < 16; ++i) { const int k = k0 + 4 * i + (lane >> 4); v[i] = v[i] * ((k < J.split) ? J.s0[k] : J.s1[k - J.split]); } }
}
__device__ __forceinline__ void conv_store(const ConvJob& J, int item, int lane, const f32x4 (&v)[16], LAS unsigned* scr  ) {
    const int nblk = J.N / 64, k0 = 64 * (item / nblk), n0 = 64 * (item % nblk);
    const int r = lane >> 4; const bool odd = r & 1; const int colb = 4 * (lane & 15) + (odd ? 2 : 0);
#pragma unroll
    for (int i = 0; i < 16; ++i) { const float a = odd ? v[i].x : v[i].z, b = odd ? v[i].y : v[i].w; const float ra = __shfl_xor(a, 16), rb = __shfl_xor(b, 16);
        const unsigned w0 = odd ? pk2(ra, v[i].z) : pk2(v[i].x, ra), w1 = odd ? pk2(rb, v[i].w) : pk2(v[i].y, rb); const int kp = 2 * i + (r >> 1);
        scr[colb * 33 + kp] = w0; scr[(colb + 1) * 33 + kp] = w1; }
    asm volatile("s_waitcnt lgkmcnt(0)" ::: "memory");
    const int c = lane & 7;
#pragma unroll
    for (int j = 0; j < 8; ++j) { const int n = (lane >> 3) + 8 * j; const LAS unsigned* s = scr + n * 33 + 4 * c;
        v4u o; o.x = s[0]; o.y = s[1]; o.z = s[2]; o.w = s[3];
        *(v4u*)(J.WT + (size_t)(n0 + n) * J.K + k0 + 8 * c) = o; }
    asm volatile("s_waitcnt lgkmcnt(0)" ::: "memory");
}
__device__ __forceinline__ void conv_run(const ConvJob& J, int first, int stride, int lane, LAS unsigned* scr) {
    const int nitems = (J.K / 64) * (J.N / 64);
    if (first >= nitems) return;
    f32x4 va[16], vb[16];
    conv_load(J, first, lane, va);
    for (int it = first; it < nitems; it += 2 * stride) {
        const bool h1 = it + stride < nitems, h2 = it + 2 * stride < nitems;
        if (h1) conv_load(J, it + stride, lane, vb);
        conv_store(J, it, lane, va, scr);
        if (h2) conv_load(J, it + 2 * stride, lane, va);
        if (h1) conv_store(J, it + stride, lane, vb, scr);
    }
}
__device__ __forceinline__ void rms_row_bf16(const float* xrow, bf16* orow, int lane) {
    const f32x4* xr = (const f32x4*)xrow + lane; f32x4 v[8]; float ss = 0.f;
#pragma unroll
    for (int j = 0; j < 8; ++j) { v[j] = xr[64 * j]; ss += (v[j].x * v[j].x + v[j].y * v[j].y) + (v[j].z * v[j].z + v[j].w * v[j].w); }
    const float rs = 1.0f / sqrtf(wave_sum(ss) * (1.0f / DM) + EPS);
    unsigned long long* o8 = (unsigned long long*)orow + lane;
#pragma unroll
    for (int j = 0; j < 8; ++j) o8[64 * j] = (unsigned long long)pk2(v[j].x * rs, v[j].y * rs) | ((unsigned long long)pk2(v[j].z * rs, v[j].w * rs) << 32);
}
__device__ __forceinline__ void final_rms_row(float* xrow, const float* g, int lane) {
    f32x4* xr = (f32x4*)xrow + lane; const f32x4* gr = (const f32x4*)g + lane; f32x4 v[8]; float ss = 0.f;
#pragma unroll
    for (int j = 0; j < 8; ++j) { v[j] = xr[64 * j]; ss += (v[j].x * v[j].x + v[j].y * v[j].y) + (v[j].z * v[j].z + v[j].w * v[j].w); }
    const float rs = 1.0f / sqrtf(wave_sum(ss) * (1.0f / DM) + EPS);
#pragma unroll
    for (int j = 0; j < 8; ++j) xr[64 * j] = v[j] * rs * gr[64 * j];
}
constexpr int SL = 32, SNC = SEQ / SL, SK = 128 + SL * 16;
typedef short bf16x8v __attribute__((ext_vector_type(8)));
typedef float f32x16 __attribute__((ext_vector_type(16)));
constexpr int TB_PA = 130, TB_PC = 130;
constexpr int TB_APOW = 0, TB_BB = 33 * TB_PA * 4, TB_CC = TB_BB + 64 * 16 * 8, TB_KT = TB_CC + 16 * TB_PC * 4, TB_END = TB_KT + 32 * 256 * 4;
__device__ __forceinline__ void ssm_build_tables(LAS unsigned char* L, int g, int q, int tid, const float* a_re, const float* a_im, const float* b_re, const float* b_im,
                                                 const float* c_re, const float* c_im, const float* log_dt, bf16* TTAB, bf16* PTAB, float* A32) {
    LAS float* apow = (LAS float*)(L + TB_APOW); LAS float* Bb = (LAS float*)(L + TB_BB); LAS float* Cc = (LAS float*)(L + TB_CC); LAS float* Kt = (LAS float*)(L + TB_KT);
    if (tid < NP) { const int p = tid, i = g * NP + p;
        const double dt = exp((double)log_dt[g]); const double lr = a_re[i], li = a_im[i];
        const double zr = lr * dt, zi = li * dt, ea = exp(zr); const double ar = ea * cos(zi), ai = ea * sin(zi);
        const double d2 = lr * lr + li * li; const double qr = ((ar - 1.0) * lr + ai * li) / d2, qi = (ai * lr - (ar - 1.0) * li) / d2;
        for (int h = 0; h < NHG; ++h) { const double br = b_re[i * NHG + h], bi = b_im[i * NHG + h]; Bb[(p * 16 + h) * 2] = (float)(qr * br - qi * bi); Bb[(p * 16 + h) * 2 + 1] = (float)(qr * bi + qi * br); }
        double pr = 1.0, pi = 0.0;
        for (int k = 0; k <= SL; ++k) { apow[k * TB_PA + p * 2] = (float)pr; apow[k * TB_PA + p * 2 + 1] = (float)pi; const double nr = pr * ar - pi * ai, ni = pr * ai + pi * ar; pr = nr; pi = ni; }
        if (q == 0) { A32[i * 2] = apow[SL * TB_PA + p * 2]; A32[i * 2 + 1] = apow[SL * TB_PA + p * 2 + 1]; }
    }
    for (int e = tid; e < 16 * 64; e += 512) { const int h = e >> 6, p = e & 63; Cc[h * TB_PC + p * 2] = c_re[g * 1024 + e]; Cc[h * TB_PC + p * 2 + 1] = c_im[g * 1024 + e]; }
    __syncthreads();
    { const int tau = tid >> 4, h = tid & 15;
      if (tau < 8 * (q + 1)) { float kk[16];
#pragma unroll
        for (int e = 0; e < 16; ++e) kk[e] = 0.f;
        for (int p = 0; p < 64; ++p) { const float cr = Cc[h * TB_PC + p * 2], ci = Cc[h * TB_PC + p * 2 + 1], ar = apow[tau * TB_PA + p * 2], ai = apow[tau * TB_PA + p * 2 + 1];
            const float wr = cr * ar - ci * ai, wi = cr * ai + ci * ar;
#pragma unroll
            for (int e = 0; e < 16; ++e) kk[e] += wr * Bb[(p * 16 + e) * 2] - wi * Bb[(p * 16 + e) * 2 + 1]; }
#pragma unroll
        for (int e = 0; e < 16; ++e) Kt[tid * 16 + e] = kk[e]; } }
    __syncthreads();
    for (int idx = tid; idx < 128 * (SK / 8); idx += 512) { const int m = 128 * q + idx / (SK / 8), k0 = (idx % (SK / 8)) * 8, t = m >> 4, h = m & 15; float v[8];
        if (k0 < 128) { const int p0 = k0 & 63; const bool im = k0 >= 64;
#pragma unroll
            for (int j = 0; j < 8; ++j) { const int p = p0 + j; const float cr = Cc[h * TB_PC + p * 2], ci = Cc[h * TB_PC + p * 2 + 1], ar = apow[(t + 1) * TB_PA + p * 2], ai = apow[(t + 1) * TB_PA + p * 2 + 1];
                v[j] = im ? -(cr * ai + ci * ar) : (cr * ar - ci * ai); } }
        else { const int s = (k0 - 128) >> 4, hp0 = (k0 - 128) & 15;
#pragma unroll
            for (int j = 0; j < 8; ++j) v[j] = (s <= t) ? Kt[(t - s) * 256 + h * 16 + hp0 + j] : 0.f; }
        v4u o; o.x = pk2(v[0], v[1]); o.y = pk2(v[2], v[3]); o.z = pk2(v[4], v[5]); o.w = pk2(v[6], v[7]);
        *(v4u*)(TTAB + ((size_t)(g * 512 + m) * SK + k0)) = o; }
    for (int idx = tid; idx < 32 * 64; idx += 512) { const int pp = 32 * q + (idx >> 6), k0 = (idx & 63) * 8, s = k0 >> 4, hp0 = k0 & 15, p = pp & 63; const bool im = pp >= 64; float v[8];
        const float ar = apow[(SL - 1 - s) * TB_PA + p * 2], ai = apow[(SL - 1 - s) * TB_PA + p * 2 + 1];
#pragma unroll
        for (int j = 0; j < 8; ++j) { const float br = Bb[(p * 16 + hp0 + j) * 2], bi = Bb[(p * 16 + hp0 + j) * 2 + 1]; v[j] = im ? (ar * bi + ai * br) : (ar * br - ai * bi); }
        v4u o; o.x = pk2(v[0], v[1]); o.y = pk2(v[2], v[3]); o.z = pk2(v[4], v[5]); o.w = pk2(v[6], v[7]);
        *(v4u*)(PTAB + ((size_t)(g * 128 + pp) * 512 + k0)) = o; }
    __syncthreads();
}
__device__ __forceinline__ void ssm_states(LAS unsigned char* L, int g, int lane, int wave, bf16* ASSM, const bf16* PTAB, const float* A32) {
    const int r32 = lane & 31, hi = lane >> 5;
    const bf16x8v* ap = (const bf16x8v*)(ASSM + (size_t)(g * SNC + 32 * wave + r32) * SK + 128 + 8 * hi);
    const bf16x8v* bp = (const bf16x8v*)(PTAB + (size_t)(g * 128 + r32) * 512 + 8 * hi);
    f32x16 acc[4];
#pragma unroll
    for (int b = 0; b < 4; ++b)
#pragma unroll
        for (int e = 0; e < 16; ++e) acc[b][e] = 0.f;
#pragma unroll 4
    for (int ks = 0; ks < 32; ++ks) { const bf16x8v a = ap[2 * ks];
#pragma unroll
        for (int b = 0; b < 4; ++b) { const bf16x8v bb = bp[(size_t)b * 32 * 512 / 8 + 2 * ks]; acc[b] = __builtin_amdgcn_mfma_f32_32x32x16_bf16(a, bb, acc[b], 0, 0, 0); } }
    float ar[2], ai[2];
#pragma unroll
    for (int b = 0; b < 2; ++b) { ar[b] = A32[(g * NP + 32 * b + r32) * 2]; ai[b] = A32[(g * NP + 32 * b + r32) * 2 + 1]; }
    LAS float* xe = (LAS float*)L;
    float xr[2], xi[2];
#define SSM_SCAN(STORE) do { _Pragma("unroll") for (int q = 0; q < 8; ++q) { const int rb = 4 * (q >> 1); const bool own = (hi == (q & 1)); \
        _Pragma("unroll") for (int j = 0; j < 4; ++j) { \
            _Pragma("unroll") for (int b = 0; b < 2; ++b) { \
                if (STORE) { if (own) { bf16* row = ASSM + (size_t)(g * SNC + 32 * wave + 4 * q + j) * SK; row[32 * b + r32] = (bf16)f2bf(xr[b]); row[64 + 32 * b + r32] = (bf16)f2bf(xi[b]); } } \
                const float nr = ar[b] * xr[b] - ai[b] * xi[b] + acc[b][rb + j], ni = ar[b] * xi[b] + ai[b] * xr[b] + acc[b + 2][rb + j]; xr[b] = nr; xi[b] = ni; } } \
        _Pragma("unroll") for (int b = 0; b < 2; ++b) { const float orr = __shfl_xor(xr[b], 32), oi = __shfl_xor(xi[b], 32); if (!own) { xr[b] = orr; xi[b] = oi; } } } } while (0)
    xr[0] = xr[1] = xi[0] = xi[1] = 0.f;
    SSM_SCAN(false);
    if (hi == 0) {
#pragma unroll
        for (int b = 0; b < 2; ++b) { xe[((wave * 64) + 32 * b + r32) * 2] = xr[b]; xe[((wave * 64) + 32 * b + r32) * 2 + 1] = xi[b]; } }
    __syncthreads();
    float sr[2], si[2];
#pragma unroll
    for (int b = 0; b < 2; ++b) { float pr = ar[b], pi = ai[b];
#pragma unroll
        for (int k = 0; k < 5; ++k) { const float nr = pr * pr - pi * pi, ni = 2.f * pr * pi; pr = nr; pi = ni; }
        sr[b] = 0.f; si[b] = 0.f;
        for (int w = 0; w < wave; ++w) { const float er = xe[((w * 64) + 32 * b + r32) * 2], ei = xe[((w * 64) + 32 * b + r32) * 2 + 1]; const float nr = pr * sr[b] - pi * si[b] + er, ni = pr * si[b] + pi * sr[b] + ei; sr[b] = nr; si[b] = ni; } }
    xr[0] = sr[0]; xr[1] = sr[1]; xi[0] = si[0]; xi[1] = si[1];
    SSM_SCAN(true);
#undef SSM_SCAN
    asm volatile("s_waitcnt vmcnt(0)" ::: "memory");
    __syncthreads();
}
namespace gp {
struct OneUnit { Unit u; __device__ __forceinline__ bool next(int i, Unit& o) const { if (i) return false; o = u; return true; } };
struct EpiSsmY {
    static constexpr bool PERM = true; const bf16_t* assm; const float* dsk; bf16_t* yact;
    __device__ __forceinline__ bool operator()(Acc& acc, const Unit& u, int wr, int wc, int fr, int fq) const {
        const int g = u.pm;
#pragma unroll
        for (int bj = 0; bj < 2; ++bj) { const int col = bj * HALF + wc * 32 + 8 * fq, t = u.pn * 16 + (col >> 4), h0 = col & 15;
            const f32x4 d0 = *(const f32x4*)(dsk + g * 16 + h0), d1 = *(const f32x4*)(dsk + g * 16 + h0 + 4);
#pragma unroll
            for (int ai = 0; ai < 2; ++ai)
#pragma unroll
                for (int m = 0; m < 4; ++m) { const int c = ai * HALF + wr * 64 + m * 16 + fr;
                    const u32x4 uw = *(const u32x4*)(assm + (size_t)(g * SNC + c) * SK + 128 + t * 16 + h0);
                    f32x4 v0 = acc[ai][bj][m][0], v1 = acc[ai][bj][m][1];
                    v0[0] += d0[0] * bflo(uw.x); v0[1] += d0[1] * bfhi(uw.x); v0[2] += d0[2] * bflo(uw.y); v0[3] += d0[3] * bfhi(uw.y);
                    v1[0] += d1[0] * bflo(uw.z); v1[1] += d1[1] * bfhi(uw.z); v1[2] += d1[2] * bflo(uw.w); v1[3] += d1[3] * bfhi(uw.w);
#pragma unroll
                    for (int e = 0; e < 4; ++e) { v0[e] = gelu_fast(v0[e]); v1[e] = gelu_fast(v1[e]); }
                    u32x4 w; w.x = cvt_pk_bf16(v0[0], v0[1]); w.y = cvt_pk_bf16(v0[2], v0[3]); w.z = cvt_pk_bf16(v1[0], v1[1]); w.w = cvt_pk_bf16(v1[2], v1[3]);
                    *(u32x4*)(yact + (size_t)(c * SL + t) * SSMW + g * 16 + h0) = w; } }
        return false;
    }
};
}
constexpr int SG_PITCH = 272;
constexpr int SG_WT = 0, SG_VT = 128 * SG_PITCH, SG_MU = 2 * 128 * SG_PITCH, SG_RS = SG_MU + 512, SG_END = SG_RS + 512;
__device__ __forceinline__ void sgu_stage_w(LAS unsigned char* L, int h, int tid, const float* sgu_w) {
    const int t = tid >> 2, s0 = (tid & 3) * 32; const float* wr = sgu_w + ((size_t)h * SGC + t) * SGC + s0;
#pragma unroll
    for (int j = 0; j < 4; ++j) { const f32x4 a = *(const f32x4*)(wr + 8 * j), b = *(const f32x4*)(wr + 8 * j + 4); const int s = s0 + 8 * j; float v[8] = {a[0], a[1], a[2], a[3], b[0], b[1], b[2], b[3]};
#pragma unroll
        for (int e = 0; e < 8; ++e) v[e] = (s + e <= t) ? v[e] : 0.f;
        v4u o; o.x = pk2(v[0], v[1]); o.y = pk2(v[2], v[3]); o.z = pk2(v[4], v[5]); o.w = pk2(v[6], v[7]);
        *(LAS v4u*)(L + SG_WT + t * SG_PITCH + s * 2) = o; }
}
__device__ __forceinline__ void sgu_item(LAS unsigned char* L, int h, int c, int tid, int lane, int wave, const bf16* VT, const float* STAT_V, const float* ln_g, const float* ln_b, const float* sgu_b,
                                         const bf16* UACT, bf16* AOUT, float* SS_SGU) {
    LAS float* MU = (LAS float*)(L + SG_MU); LAS float* RS = (LAS float*)(L + SG_RS);
    if (tid < SGC) { const int tok = c * SGC + tid; const float s1 = STAT_V[2 * tok], s2 = STAT_V[2 * tok + 1]; const float mu = s1 * (1.0f / SGUW); const float var = s2 * (1.0f / SGUW) - mu * mu;
        MU[tid] = mu; RS[tid] = 1.0f / sqrtf(var + EPS); }
    __syncthreads();
    { const int d = tid >> 2, s0 = (tid & 3) * 32, ch = h * SGD + d; const float gg = ln_g[ch], bb = ln_b[ch]; const bf16* vr = VT + (size_t)ch * SEQ + c * SGC + s0;
#pragma unroll
      for (int j = 0; j < 4; ++j) { const v4u w = *(const v4u*)(vr + 8 * j); const int s = s0 + 8 * j; float v[8] = {bflo(w.x), bfhi(w.x), bflo(w.y), bfhi(w.y), bflo(w.z), bfhi(w.z), bflo(w.w), bfhi(w.w)};
#pragma unroll
          for (int e = 0; e < 8; ++e) v[e] = (v[e] - MU[s + e]) * RS[s + e] * gg + bb;
          v4u o; o.x = pk2(v[0], v[1]); o.y = pk2(v[2], v[3]); o.z = pk2(v[4], v[5]); o.w = pk2(v[6], v[7]);
          *(LAS v4u*)(L + SG_VT + d * SG_PITCH + s * 2) = o; } }
    __syncthreads();
    const int fr = lane & 15, fq = lane >> 4; const int nkb = (wave >> 1) + 1;
    f32x4 acc[8];
#pragma unroll
    for (int nb = 0; nb < 8; ++nb) acc[nb] = (f32x4){0.f, 0.f, 0.f, 0.f};
    for (int kb = 0; kb < nkb; ++kb) { const bf16x8v wf = *(const LAS bf16x8v*)(L + SG_WT + (16 * wave + fr) * SG_PITCH + (32 * kb + 8 * fq) * 2);
#pragma unroll
        for (int nb = 0; nb < 8; ++nb) { const bf16x8v vf = *(const LAS bf16x8v*)(L + SG_VT + (16 * nb + fr) * SG_PITCH + (32 * kb + 8 * fq) * 2);
            acc[nb] = __builtin_amdgcn_mfma_f32_16x16x32_bf16(vf, wf, acc[nb], 0, 0, 0); } }
    const int t = 16 * wave + fr, token = c * SGC + t; const float bias = sgu_b[h * SGC + t]; float ss = 0.f;
#pragma unroll
    for (int nb = 0; nb < 8; ++nb) { const int d0 = 16 * nb + 4 * fq; const uint2 uw = *(const uint2*)(UACT + (size_t)token * SGUW + h * SGD + d0);
        const float o0 = bflo(uw.x) * (acc[nb][0] + bias), o1 = bfhi(uw.x) * (acc[nb][1] + bias), o2 = bflo(uw.y) * (acc[nb][2] + bias), o3 = bfhi(uw.y) * (acc[nb][3] + bias);
        ss += (o0 * o0 + o1 * o1) + (o2 * o2 + o3 * o3);
        uint2 ow; ow.x = pk2(o0, o1); ow.y = pk2(o2, o3); *(uint2*)(AOUT + (size_t)token * DM + SSMW + h * SGD + d0) = ow; }
    ss += __shfl_xor(ss, 16); ss += __shfl_xor(ss, 32);
    if (fq == 0) (void)__hip_atomic_fetch_add(SS_SGU + token, ss, __ATOMIC_RELAXED, __HIP_MEMORY_SCOPE_AGENT);
    __syncthreads();
}
namespace gp {
struct P1Sched { StaticOrder so; const char* X; const char* W; int ld;
    __device__ __forceinline__ bool next(int i, Unit& u) const { pg8::Unit q; if (!so.next(i, q)) return false; u.pm = q.pm; u.pn = q.pn; u.nt = DM / BK;
        const char* xa = X + (size_t)q.pm * BM * ld; const char* wb = W + (size_t)q.pn * BM * ld;
        if (q.pn < 8) { u.a = xa; u.b = wb; u.kind = q.pn < 4 ? 0 : 1; } else { u.a = wb; u.b = xa; u.kind = 2; } return true; }
};
struct EpiP1 {
    static constexpr bool PERM = true; bf16_t* assm; bf16_t* uact; bf16_t* vt; float* statv;
    __device__ __forceinline__ bool operator()(Acc& acc, const Unit& u, int wr, int wc, int fr, int fq) const {
        if (u.kind == 2) {
            float s[2][8], q[2][8];
#pragma unroll
            for (int bj = 0; bj < 2; ++bj)
#pragma unroll
                for (int e = 0; e < 8; ++e) { s[bj][e] = 0.f; q[bj][e] = 0.f; }
            const int ch0 = (u.pn - 8) * BM + wr * 64 + fr, tok0 = u.pm * BM + wc * 32 + 8 * fq;
#pragma unroll
            for (int ai = 0; ai < 2; ++ai)
#pragma unroll
                for (int m = 0; m < 4; ++m) { bf16_t* rowp = vt + (size_t)(ch0 + ai * HALF + m * 16) * SEQ + tok0;
#pragma unroll
                    for (int bj = 0; bj < 2; ++bj) { float v[8];
#pragma unroll
                        for (int e = 0; e < 8; ++e) { v[e] = gelu_fast(acc[ai][bj][m][e >> 2][e & 3]); s[bj][e] += v[e]; q[bj][e] += v[e] * v[e]; }
                        u32x4 w; w.x = cvt_pk_bf16(v[0], v[1]); w.y = cvt_pk_bf16(v[2], v[3]); w.z = cvt_pk_bf16(v[4], v[5]); w.w = cvt_pk_bf16(v[6], v[7]);
                        *(u32x4*)(rowp + bj * HALF) = w; } }
#pragma unroll
            for (int bj = 0; bj < 2; ++bj)
#pragma unroll
                for (int e = 0; e < 8; ++e) {
#pragma unroll
                    for (int o = 1; o < 16; o <<= 1) { s[bj][e] += __shfl_xor(s[bj][e], o); q[bj][e] += __shfl_xor(q[bj][e], o); }
                    if (fr == 0) { float* st = statv + (size_t)(tok0 + bj * HALF + e) * 2;
                        (void)__hip_atomic_fetch_add(st, s[bj][e], __ATOMIC_RELAXED, __HIP_MEMORY_SCOPE_AGENT); (void)__hip_atomic_fetch_add(st + 1, q[bj][e], __ATOMIC_RELAXED, __HIP_MEMORY_SCOPE_AGENT); } }
            return false;
        }
        const int row0 = u.pm * BM + wr * 64 + fr, col0 = u.pn * BM + wc * 32 + 8 * fq;
#pragma unroll
        for (int ai = 0; ai < 2; ++ai)
#pragma unroll
            for (int m = 0; m < 4; ++m) { const int row = row0 + ai * HALF + m * 16;
#pragma unroll
                for (int bj = 0; bj < 2; ++bj) { f32x4 v0 = acc[ai][bj][m][0], v1 = acc[ai][bj][m][1]; const int col = col0 + bj * HALF;
                    if (u.kind == 1) {
#pragma unroll
                        for (int e = 0; e < 4; ++e) { v0[e] = gelu_fast(v0[e]); v1[e] = gelu_fast(v1[e]); } }
                    u32x4 w; w.x = cvt_pk_bf16(v0[0], v0[1]); w.y = cvt_pk_bf16(v0[2], v0[3]); w.z = cvt_pk_bf16(v1[0], v1[1]); w.w = cvt_pk_bf16(v1[2], v1[3]);
                    if (u.kind == 0) *(u32x4*)(assm + (size_t)((col >> 4) * SNC + (row >> 5)) * SK + 128 + (row & 31) * 16 + (col & 15)) = w;
                    else *(u32x4*)(uact + (size_t)row * SGUW + (col - SSMW)) = w; } }
        return false;
    }
};
struct EpiGlu {
    static constexpr bool PERM = true; const bf16_t* yact; const float* gb; bf16_t* aout; float* ss;
    __device__ __forceinline__ bool operator()(Acc& acc, const Unit& u, int wr, int wc, int fr, int fq) const {
        const int row0 = u.pm * BM + wr * 64 + fr, col0 = u.pn * BM + wc * 32 + 8 * fq;
        f32x4 b0[2], b1[2];
#pragma unroll
        for (int bj = 0; bj < 2; ++bj) { b0[bj] = *(const f32x4*)(gb + col0 + bj * HALF); b1[bj] = *(const f32x4*)(gb + col0 + bj * HALF + 4); }
#pragma unroll
        for (int ai = 0; ai < 2; ++ai)
#pragma unroll
            for (int m = 0; m < 4; ++m) { const int row = row0 + ai * HALF + m * 16; float rs = 0.f;
#pragma unroll
                for (int bj = 0; bj < 2; ++bj) { const int col = col0 + bj * HALF; const u32x4 yw = *(const u32x4*)(yact + (size_t)row * SSMW + col);
                    const f32x4 z0 = acc[ai][bj][m][0] + b0[bj], z1 = acc[ai][bj][m][1] + b1[bj]; float o[8];
                    const float y[8] = {bflo(yw.x), bfhi(yw.x), bflo(yw.y), bfhi(yw.y), bflo(yw.z), bfhi(yw.z), bflo(yw.w), bfhi(yw.w)};
#pragma unroll
                    for (int e = 0; e < 8; ++e) { const float z = e < 4 ? z0[e & 3] : z1[e & 3]; o[e] = y[e] / (1.0f + __expf(-z)); rs += o[e] * o[e]; }
                    u32x4 w; w.x = cvt_pk_bf16(o[0], o[1]); w.y = cvt_pk_bf16(o[2], o[3]); w.z = cvt_pk_bf16(o[4], o[5]); w.w = cvt_pk_bf16(o[6], o[7]);
                    *(u32x4*)(aout + (size_t)row * DM + col) = w; }
                rs += __shfl_xor(rs, 16); rs += __shfl_xor(rs, 32);
                if (fq == 0) (void)__hip_atomic_fetch_add(ss + row, rs, __ATOMIC_RELAXED, __HIP_MEMORY_SCOPE_AGENT); }
        return false;
    }
};
struct OutSched { StaticOrder so; const char* A; const char* B; int ld;
    __device__ __forceinline__ bool next(int i, Unit& u) const { pg8::Unit q; if (!so.next(i >> 1, q)) return false; const int half = i & 1; u.pm = q.pm; u.pn = q.pn; u.nt = SSMW / BK; u.kind = half;
        u.a = A + (size_t)q.pm * BM * ld + half * (SSMW * 2); u.b = B + (size_t)q.pn * BM * ld + half * (SSMW * 2); return true; }
};
struct EpiOut {
    static constexpr bool PERM = true; const float* base; float* out; bf16_t* abf; float* ss; const float* ss_a; const float* ss_b;
    __device__ __forceinline__ bool operator()(Acc& acc, const Unit& u, int wr, int wc, int fr, int fq) const {
        const int row0 = u.pm * BM + wr * 64 + fr, col0 = u.pn * BM + wc * 32 + 8 * fq;
#pragma unroll
        for (int ai = 0; ai < 2; ++ai)
#pragma unroll
            for (int m = 0; m < 4; ++m) { const int row = row0 + ai * HALF + m * 16; const size_t off = (size_t)row * DM + col0;
                const float ra = 1.0f / sqrtf(ss_a[row] * (1.0f / SSMW) + EPS), rb = 1.0f / sqrtf(ss_b[row] * (1.0f / SGUW) + EPS);
                if (u.kind == 0) { const float f = ra / rb;
#pragma unroll
                    for (int bj = 0; bj < 2; ++bj) { acc[ai][bj][m][0] *= f; acc[ai][bj][m][1] *= f; } }
                else { float rs = 0.f;
#pragma unroll
                    for (int bj = 0; bj < 2; ++bj) { const f32x4 v0 = acc[ai][bj][m][0] * rb + *(const f32x4*)(base + off + bj * HALF), v1 = acc[ai][bj][m][1] * rb + *(const f32x4*)(base + off + bj * HALF + 4);
                        *(f32x4*)(out + off + bj * HALF) = v0; *(f32x4*)(out + off + bj * HALF + 4) = v1;
                        rs += (v0[0] * v0[0] + v0[1] * v0[1]) + (v0[2] * v0[2] + v0[3] * v0[3]) + (v1[0] * v1[0] + v1[1] * v1[1]) + (v1[2] * v1[2] + v1[3] * v1[3]);
                        u32x4 w; w.x = cvt_pk_bf16(v0[0], v0[1]); w.y = cvt_pk_bf16(v0[2], v0[3]); w.z = cvt_pk_bf16(v1[0], v1[1]); w.w = cvt_pk_bf16(v1[2], v1[3]); *(u32x4*)(abf + off + bj * HALF) = w; }
                    rs += __shfl_xor(rs, 16); rs += __shfl_xor(rs, 32);
                    if (fq == 0) (void)__hip_atomic_fetch_add(ss + row, rs, __ATOMIC_RELAXED, __HIP_MEMORY_SCOPE_AGENT); } }
        return u.kind == 0;
    }
};
}
#ifndef MK_N_LAUNCHES
#define MK_N_LAUNCHES 1
#endif
constexpr int PER_PHASE = 8;
constexpr int N_LAUNCHES = MK_N_LAUNCHES;
struct Args { const float* in[24]; float* out; unsigned char* ws; int ph_lo, ph_hi; };
static_assert(sizeof(Args) == 24 * 8 + 8 + 8 + 8, "Args has no padding");

__global__ void __launch_bounds__(NWAVES * 64, 2) fwd(Args args) {
    extern __shared__ __attribute__((aligned(16))) unsigned char lds_raw[];
    LAS unsigned char* L = (LAS unsigned char*)lds_raw;
    const int tid = threadIdx.x, lane = tid & 63, wave = __builtin_amdgcn_readfirstlane(tid >> 6);
    const int gw = blockIdx.x * NWAVES + wave, ngw = gridDim.x * NWAVES;
    volatile LAS unsigned* MISC = (volatile LAS unsigned*)(L + MISC_OFF);
    for (int u = tid; u < 32; u += NWAVES * 64) MISC[u] = 0u;
    __syncthreads();
    unsigned char* ws = args.ws;
    XcdBarrier bar; bar.bar = (unsigned*)(ws + WS_CTL) + CW_BAR; bar.x = 0; bar.st = nullptr;
    if (N_LAUNCHES != PER_PHASE) bar = xcd_barrier_post((unsigned*)(ws + WS_CTL) + CW_BAR, MISC + 8);
    const float* x = args.in[0]; const float* g_mix = args.in[1]; const float* w_in = args.in[2];
    const float* a_re = args.in[3]; const float* a_im = args.in[4]; const float* b_re = args.in[5]; const float* b_im = args.in[6];
    const float* c_re = args.in[7]; const float* c_im = args.in[8]; const float* ssm_d = args.in[9]; const float* log_dt = args.in[10];
    const float* glu_w = args.in[11]; const float* glu_b = args.in[12]; const float* ln_g = args.in[13]; const float* ln_b = args.in[14];
    const float* sgu_w = args.in[15]; const float* sgu_b = args.in[16]; const float* g_ssm = args.in[17]; const float* g_sgu = args.in[18];
    const float* w_out = args.in[19]; const float* g_mlp = args.in[20]; const float* w_up = args.in[21]; const float* w_down = args.in[22];
    const float* g_fin = args.in[23];
    float* out = args.out;
    bf16* WUPT = (bf16*)(ws + WS_WUPT); bf16* WDOWNT = (bf16*)(ws + WS_WDOWNT); bf16* AMLP = (bf16*)(ws + WS_AMLP); bf16* H = (bf16*)(ws + WS_H);
    bf16* WINT = (bf16*)(ws + WS_WINT); bf16* GLUT = (bf16*)(ws + WS_GLUT); bf16* WOUTT = (bf16*)(ws + WS_WOUTT); bf16* H0 = (bf16*)(ws + WS_H0);
    bf16* VT = (bf16*)(ws + WS_VT); bf16* UACT = (bf16*)(ws + WS_UACT); bf16* YACT = (bf16*)(ws + WS_YACT); bf16* AOUT = (bf16*)(ws + WS_AOUT);
    bf16* TTAB = (bf16*)(ws + WS_TTAB); bf16* PTAB = (bf16*)(ws + WS_PTAB); bf16* ASSM = (bf16*)(ws + WS_ASSM); float* A32 = (float*)(ws + WS_A32);
    float* SS_X1 = (float*)(ws + WS_STAT); float* SS_X2 = SS_X1 + SEQ; float* SS_SSM = SS_X2 + SEQ; float* SS_SGU = SS_SSM + SEQ; float* STAT_V = SS_SGU + SEQ;

    const int lo = args.ph_lo, hi = args.ph_hi;
#define IN(k) (lo <= (k) && (k) < hi)
#define SEAM(k) do { PROBE_STAMP(20 + (k)); if (IN(k) && IN((k) + 1)) xcd_barrier(bar); PROBE_STAMP((k) + 1); } while (0)
#if PROBE
#define PROBE_STAMP(i) do { if (blockIdx.x == PROBE_BLK && tid == 0) MISC[(i)] = (unsigned)__builtin_amdgcn_s_memrealtime(); } while (0)
    PROBE_STAMP(0);
#else
#define PROBE_STAMP(i) do { } while (0)
#endif
#define GEMM_PHASE(EPI, A_, BT_, M_, N_, K_, ...) do { gp::StdSched S; S.init(A_, BT_, M_, N_, K_, (int)gridDim.x, (int)blockIdx.x); \
        EPI Ep{__VA_ARGS__}; gp::gemm_phase<EPI, gp::StdSched, true, true>(L + RING_OFF, (K_) * 2, S, Ep); } while (0)

    if (IN(0)) {
        if (blockIdx.x < 4 * NG) ssm_build_tables(L + RING_OFF, (int)blockIdx.x >> 2, (int)blockIdx.x & 3, tid, a_re, a_im, b_re, b_im, c_re, c_im, log_dt, TTAB, PTAB, A32); PROBE_STAMP(12);
        { LAS unsigned* scr = (LAS unsigned*)(L + RING_OFF + wave * 16384);
          const ConvJob j_in{w_in, g_mix, g_mix, WINT, DM, INW, DM}, j_glu{glu_w, nullptr, nullptr, GLUT, SSMW, SSMW, 0}, j_out{w_out, g_ssm, g_sgu, WOUTT, DM, DM, SSMW};
          conv_run(j_in, gw, ngw, lane, scr); conv_run(j_glu, gw, ngw, lane, scr); conv_run(j_out, gw, ngw, lane, scr); }
        for (int r = gw; r < SEQ; r += ngw) rms_row_bf16(x + (size_t)r * DM, H0 + (size_t)r * DM, lane);
        for (int i = blockIdx.x * (NWAVES * 64) + tid; i < 6 * SEQ; i += gridDim.x * (NWAVES * 64)) SS_X1[i] = 0.f;
    }
    SEAM(0);
    if (IN(1)) {
        { gp::P1Sched S; S.so.init(SEQ, INW, (int)gridDim.x, (int)blockIdx.x); S.X = (const char*)H0; S.W = (const char*)WINT; S.ld = DM * 2;
          gp::EpiP1 Ep{ASSM, UACT, VT, STAT_V};
          gp::gemm_phase<gp::EpiP1, gp::P1Sched, true, true>(L + RING_OFF, DM * 2, S, Ep); } PROBE_STAMP(11);
        if ((int)blockIdx.x >= 128) {
            __syncthreads();
            LAS unsigned* scr = (LAS unsigned*)(L + RING_OFF + wave * 16384);
            const ConvJob j_up{w_up, g_mlp, g_mlp, WUPT, DM, DFF, DM}, j_dn{w_down, nullptr, nullptr, WDOWNT, DFF, DM, 0};
            const int cw = ((int)blockIdx.x - 128) * NWAVES + wave, ncw = ((int)gridDim.x - 128) * NWAVES;
            conv_run(j_up, cw, ncw, lane, scr); conv_run(j_dn, cw, ncw, lane, scr);
        }
    }
    SEAM(1);
    if (IN(2)) {
        if (blockIdx.x < 2 * NG) { const int g = (int)blockIdx.x >> 1, hf = (int)blockIdx.x & 1;
            ssm_states(L + RING_OFF, g, lane, wave, ASSM, PTAB, A32); PROBE_STAMP(10);
            gp::OneUnit S; S.u.a = (const char*)(ASSM + (size_t)g * SNC * SK); S.u.b = (const char*)(TTAB + (size_t)(g * 512 + hf * 256) * SK); S.u.pm = g; S.u.pn = hf; S.u.nt = hf ? 10 : 6; S.u.kind = 0;
            gp::EpiSsmY Ep{ASSM, ssm_d, YACT};
            gp::gemm_phase<gp::EpiSsmY, gp::OneUnit, true, true>(L + RING_OFF, SK * 2, S, Ep);
        } else {
            const int nw = (int)gridDim.x - 2 * NG;
            for (int it0 = ((int)blockIdx.x - 2 * NG) * 4; it0 < SGH * (SEQ / SGC); it0 += nw * 4) { const int h = it0 >> 6;
                sgu_stage_w(L + RING_OFF, h, tid, sgu_w);
                for (int i = 0; i < 4; ++i) sgu_item(L + RING_OFF, h, (it0 & 63) + i, tid, lane, wave, VT, STAT_V, ln_g, ln_b, sgu_b, UACT, AOUT, SS_SGU);
            }
        }
    }
    SEAM(2);
    if (IN(3)) GEMM_PHASE(gp::EpiGlu, YACT, GLUT, SEQ, SSMW, SSMW, YACT, glu_b, AOUT, SS_SSM);
    SEAM(3);
    if (IN(4)) { gp::OutSched S; S.so.init(SEQ, DM, (int)gridDim.x, (int)blockIdx.x); S.A = (const char*)AOUT; S.B = (const char*)WOUTT; S.ld = DM * 2;
        gp::EpiOut Ep{x, out, AMLP, SS_X1, SS_SSM, SS_SGU};
        gp::gemm_phase<gp::EpiOut, gp::OutSched, true, true>(L + RING_OFF, DM * 2, S, Ep); }
    SEAM(4);
    if (IN(5)) GEMM_PHASE(gp::EpiH, AMLP, WUPT, SEQ, DFF, DM, H, SS_X1, DFF, 1.0f / DM, EPS);
    SEAM(5);
    if (IN(6)) GEMM_PHASE(gp::EpiRes, H, WDOWNT, SEQ, DM, DFF, out, out, nullptr, SS_X2, DM);
    SEAM(6);
    if (IN(7)) { for (int r = gw; r < SEQ; r += ngw) { const float rs = 1.0f / sqrtf(SS_X2[r] * (1.0f / DM) + EPS);
        f32x4* xr = (f32x4*)(out + (size_t)r * DM) + lane; const f32x4* gr = (const f32x4*)g_fin + lane;
#pragma unroll
        for (int j = 0; j < 8; ++j) xr[64 * j] = xr[64 * j] * rs * gr[64 * j]; } }
#if PROBE
    if (blockIdx.x == PROBE_BLK) {
        __syncthreads();
        const unsigned dt = MISC[PROBE_A1] - MISC[PROBE_A0]; const unsigned t0 = (unsigned)__builtin_amdgcn_s_memrealtime();
        while ((unsigned)__builtin_amdgcn_s_memrealtime() - t0 < dt) __builtin_amdgcn_s_sleep(8);
    }
#endif
#undef IN
#undef SEAM
}

extern "C" void kernel_launch(void* const* d_in, const int* in_sizes, int n_in, void* d_out, int out_size, void* d_ws, size_t ws_size, hipStream_t stream) {
    static int grid = 0;
    if (grid == 0) {
        if (n_in != 24 || ws_size < WS_END) { fprintf(stderr, "kernel_launch: unexpected n_in %d / ws %zu\n", n_in, ws_size); grid = -1; return; }
        int dev = 0, cus = 0, per_cu = 0;
        if (hipGetDevice(&dev) != hipSuccess || hipDeviceGetAttribute(&cus, hipDeviceAttributeMultiprocessorCount, dev) != hipSuccess) { grid = -1; return; }
        if (hipFuncSetAttribute((const void*)fwd, hipFuncAttributeMaxDynamicSharedMemorySize, LDS_BYTES) != hipSuccess) { fprintf(stderr, "kernel_launch: hipFuncSetAttribute failed\n"); grid = -1; return; }
        if (hipOccupancyMaxActiveBlocksPerMultiprocessor(&per_cu, (const void*)fwd, NWAVES * 64, LDS_BYTES) != hipSuccess || per_cu < 1) { fprintf(stderr, "kernel_launch: occupancy query says %d blocks per CU\n", per_cu); }
        (void)hipGetLastError();
        grid = cus;
    }
    if (grid < 0) return;
    (void)hipMemsetAsync((char*)d_ws + WS_CTL, 0, CTL_ZERO_BYTES, stream);
    Args a{};
    for (int i = 0; i < 24; ++i) a.in[i] = (const float*)d_in[i];
    a.out = (float*)d_out; a.ws = (unsigned char*)d_ws;
    if (N_LAUNCHES == 1) { a.ph_lo = 0; a.ph_hi = PER_PHASE; hipLaunchKernelGGL(fwd, dim3(grid), dim3(NWAVES * 64), LDS_BYTES, stream, a); }
    else { for (int p = 0; p < PER_PHASE; ++p) { a.ph_lo = p; a.ph_hi = p + 1; hipLaunchKernelGGL(fwd, dim3(grid), dim3(NWAVES * 64), LDS_BYTES, stream, a); } }
}
```
